# Optimizing an MI355X kernel written in HIP

```python
import jax, jax.numpy as jnp
from jax import lax
import numpy as np

D_MODEL = 1024
BATCH = 8
SEQ = 2048
DEPTH = 2
DEC_BATCH = 4
DEC_SEQ = 8192
PAST_LEN = 128

W_CONV = D_MODEL
CONV_HEADS = 8
CONV_K = 3
W_POOL = D_MODEL
POOL_WINDOWS = (2, 4, 8, 16)
N_POOL = len(POOL_WINDOWS)
POOL_DH = W_POOL // N_POOL
W_SGU = D_MODEL
SGU_HEADS = 4
SGU_DH = W_SGU // SGU_HEADS
CHUNK = 128
W_FNET = D_MODEL
FNET_GROUPS = 4
FNET_DH = W_FNET // FNET_GROUPS

N_EVEN = (DEPTH + 1) // 2
N_ODD = DEPTH // 2
EVEN_SPLITS = tuple(int(s) for s in np.cumsum([W_CONV, W_CONV, W_CONV, W_CONV, W_POOL]))
EVEN_IN = 4 * W_CONV + 2 * W_POOL
ODD_SPLITS = tuple(int(s) for s in np.cumsum([W_SGU, W_SGU, W_SGU, W_FNET]))
ODD_IN = 3 * W_SGU + 2 * W_FNET
EPS = 1e-6

kernel_name = "hybrid_conv_pool_sgu_fnet_encoder"


def rmsnorm(x, g):
    x32 = x.astype(jnp.float32)
    y = x32 * lax.rsqrt(jnp.mean(x32 * x32, axis=-1, keepdims=True) + EPS)
    return (y * g.astype(jnp.float32)).astype(x.dtype)


def short_conv_mixer(h, gb, gc, w):
    u = gc * h
    s = u.shape[1]
    pad = CONV_K // 2
    up = jnp.pad(u, ((0, 0), (pad, pad), (0, 0)))
    y = up[:, 0:s] * w[0]
    for k in range(1, CONV_K):
        y = y + up[:, k:k + s] * w[k]
    return gb * y


def multiscale_pool_mixer(v, w_grp, scale):
    bsz, s, _ = v.shape
    v32 = v.astype(jnp.float32)
    cs = jnp.concatenate([jnp.zeros((bsz, 1, W_POOL), jnp.float32), jnp.cumsum(v32, axis=1)], axis=1)
    t = np.arange(s)
    outs = []
    for g, win in enumerate(POOL_WINDOWS):
        lo = np.clip(t - win // 2, 0, s)
        hi = np.clip(t + win - win // 2, 0, s)
        cnt = (hi - lo).astype(np.float32)
        csg = cs[:, :, g * POOL_DH:(g + 1) * POOL_DH]
        mean = (csg[:, hi] - csg[:, lo]) / cnt[None, :, None]
        outs.append(mean - v32[:, :, g * POOL_DH:(g + 1) * POOL_DH])
    d = jnp.stack(outs, axis=2)
    y = jnp.einsum('bsgc,gcd->bsgd', d, w_grp.astype(jnp.float32)).reshape(bsz, s, W_POOL)
    return (y * scale.astype(jnp.float32)).astype(v.dtype)


def chunked_sgu(u, v, g_norm, w_s, b_s):
    bsz, s, _ = v.shape
    v32 = v.astype(jnp.float32).reshape(bsz, s // CHUNK, CHUNK, SGU_HEADS, SGU_DH)
    mu = jnp.mean(v32, axis=-1, keepdims=True)
    var = jnp.mean(jnp.square(v32 - mu), axis=-1, keepdims=True)
    vn = (v32 - mu) * lax.rsqrt(var + EPS) * g_norm.astype(jnp.float32).reshape(SGU_HEADS, SGU_DH)
    mix = jnp.einsum('hqp,bnphd->bnqhd', w_s.astype(jnp.float32), vn)
    mix = mix + jnp.transpose(b_s.astype(jnp.float32))[None, None, :, :, None]
    return u * mix.reshape(bsz, s, W_SGU).astype(u.dtype)


def fourier_mixer(f, w_grp):
    bsz, s, _ = f.shape
    f32 = f.astype(jnp.float32).reshape(bsz, s, FNET_GROUPS, FNET_DH)
    spec = jnp.real(jnp.fft.fft2(f32, axes=(1, 3), norm='ortho')).astype(jnp.float32)
    y = jnp.einsum('bsgc,gcd->bsgd', spec, w_grp.astype(jnp.float32))
    return y.reshape(bsz, s, W_FNET).astype(f.dtype)


def even_layer(x, g, w_in, conv_w, pool_w, pool_scale, w_out):
    h = rmsnorm(x, g)
    p = jnp.einsum('bsd,de->bse', h, w_in)
    a_h, a_b, a_c, a_z, b_v, b_z = jnp.split(p, EVEN_SPLITS, axis=-1)
    y_a = short_conv_mixer(a_h, a_b, a_c, conv_w) * jax.nn.silu(a_z)
    y_b = multiscale_pool_mixer(b_v, pool_w, pool_scale) * jax.nn.silu(b_z)
    y = jnp.concatenate([y_a, y_b], axis=-1)
    return x + jnp.einsum('bse,ed->bsd', y, w_out)


def odd_layer(x, g, w_in, sgu_norm_g, sgu_ws, sgu_bs, fnet_w, w_out):
    h = rmsnorm(x, g)
    p = jnp.einsum('bsd,de->bse', h, w_in)
    c_u, c_v, c_z, d_f, d_z = jnp.split(p, ODD_SPLITS, axis=-1)
    y_c = chunked_sgu(c_u, c_v, sgu_norm_g, sgu_ws, sgu_bs) * jax.nn.silu(c_z)
    y_d = fourier_mixer(d_f, fnet_w) * jax.nn.silu(d_z)
    y = jnp.concatenate([y_c, y_d], axis=-1)
    return x + jnp.einsum('bse,ed->bsd', y, w_out)


def trunk(x, norm_g, ev_w_in, ev_conv_w, ev_pool_w, ev_pool_scale, ev_w_out,
          od_w_in, od_sgu_norm_g, od_sgu_ws, od_sgu_bs, od_fnet_w, od_w_out, final_g):
    for i in range(DEPTH):
        j = i // 2
        if i % 2 == 0:
            x = even_layer(x, norm_g[i], ev_w_in[j], ev_conv_w[j], ev_pool_w[j], ev_pool_scale[j], ev_w_out[j])
        else:
            x = odd_layer(x, norm_g[i], od_w_in[j], od_sgu_norm_g[j], od_sgu_ws[j], od_sgu_bs[j], od_fnet_w[j], od_w_out[j])
    return rmsnorm(x, final_g)


def setup_inputs(seed: int = 0) -> dict:
    key = jax.random.key(seed)
    ks = jax.random.split(key, 16)
    f32 = jnp.float32
    nrm = lambda k, shp: jax.random.normal(k, shp, f32)
    return {
        "x_prompt": nrm(ks[0], (BATCH, SEQ, D_MODEL)),
        "x_sample": nrm(ks[1], (DEC_BATCH, DEC_SEQ, D_MODEL)),
        "norm_g": 1.0 + 0.05 * nrm(ks[2], (DEPTH, D_MODEL)),
        "ev_w_in": nrm(ks[3], (N_EVEN, D_MODEL, EVEN_IN)) * D_MODEL ** -0.5,
        "ev_conv_w": nrm(ks[4], (N_EVEN, CONV_K, W_CONV)) * CONV_K ** -0.5,
        "ev_pool_w": nrm(ks[5], (N_EVEN, N_POOL, POOL_DH, POOL_DH)) * POOL_DH ** -0.5,
        "ev_pool_scale": 1.0 + 0.1 * nrm(ks[6], (N_EVEN, W_POOL)),
        "ev_w_out": nrm(ks[7], (N_EVEN, W_CONV + W_POOL, D_MODEL)) * (0.5 * (W_CONV + W_POOL) ** -0.5),
        "od_w_in": nrm(ks[8], (N_ODD, D_MODEL, ODD_IN)) * D_MODEL ** -0.5,
        "od_sgu_norm_g": 1.0 + 0.05 * nrm(ks[9], (N_ODD, W_SGU)),
        "od_sgu_ws": nrm(ks[10], (N_ODD, SGU_HEADS, CHUNK, CHUNK)) * CHUNK ** -0.5,
        "od_sgu_bs": 0.02 * nrm(ks[11], (N_ODD, SGU_HEADS, CHUNK)),
        "od_fnet_w": nrm(ks[12], (N_ODD, FNET_GROUPS, FNET_DH, FNET_DH)) * FNET_DH ** -0.5,
        "od_w_out": nrm(ks[13], (N_ODD, W_SGU + W_FNET, D_MODEL)) * (0.5 * (W_SGU + W_FNET) ** -0.5),
        "final_g": 1.0 + 0.05 * nrm(ks[14], (D_MODEL,)),
    }


def reference(x_prompt, x_sample, norm_g, ev_w_in, ev_conv_w, ev_pool_w, ev_pool_scale, ev_w_out,
              od_w_in, od_sgu_norm_g, od_sgu_ws, od_sgu_bs, od_fnet_w, od_w_out, final_g):
    y_prompt = trunk(x_prompt, norm_g, ev_w_in, ev_conv_w, ev_pool_w, ev_pool_scale, ev_w_out,
                     od_w_in, od_sgu_norm_g, od_sgu_ws, od_sgu_bs, od_fnet_w, od_w_out, final_g)
    y_sample = trunk(x_sample, norm_g, ev_w_in, ev_conv_w, ev_pool_w, ev_pool_scale, ev_w_out,
                     od_w_in, od_sgu_norm_g, od_sgu_ws, od_sgu_bs, od_fnet_w, od_w_out, final_g)
    return (y_prompt, y_sample)
```

```cpp
#include <hip/hip_runtime.h>
#include <hip/hip_cooperative_groups.h>
#include <cstdio>
#include <cstdint>
namespace cg = cooperative_groups;

#define LAS __attribute__((address_space(3)))
typedef unsigned short bf16_t;
typedef short bf16x8 __attribute__((ext_vector_type(8)));
typedef float f32x4 __attribute__((ext_vector_type(4)));
typedef unsigned u32x4 __attribute__((ext_vector_type(4)));
typedef unsigned u32x2 __attribute__((ext_vector_type(2)));

constexpr int D = 1024, NTOK = 49152, GT = 16384, NGRP = 3;
constexpr int NP = 6144;
constexpr int NP0 = 4096 + 64;
constexpr int NP1 = 5120 + 64;
constexpr int YP = 2048 + 64;
constexpr int VBLK = 257;
constexpr float EPS = 1e-6f;
constexpr int LDS_MISC = 147456;
constexpr int LDS_BYTES = 147456 + 256;
constexpr int NTHREADS = 512;

constexpr size_t OFF_W1T = 0;
constexpr size_t OFF_W3T = OFF_W1T + 12582912;
constexpr size_t OFF_W2T = OFF_W3T + 12582912;
constexpr size_t OFF_W4T = OFF_W2T + 4194304;
constexpr size_t OFF_WBV = OFF_W4T + 4194304;
constexpr size_t OFF_WF  = OFF_WBV + 2097152;
constexpr size_t OFF_PWT = OFF_WF + 2097152;
constexpr size_t OFF_FWT = OFF_PWT + 524288;
constexpr size_t OFF_CS  = OFF_FWT + 524288;
constexpr size_t OFF_MT  = OFF_CS + 262144;
constexpr size_t OFF_WSB = OFF_MT + 1048576;
constexpr size_t OFF_T1S = OFF_WSB + 131072;
constexpr size_t OFF_T1P = OFF_T1S + 4194304;
constexpr size_t OFF_T2  = OFF_T1P + 262144;
constexpr size_t OFF_BAR = OFF_T2 + 65536;
constexpr size_t OFF_STAT = OFF_BAR + 16384;
constexpr size_t OFF_H   = 50331648;
constexpr size_t OFF_P   = OFF_H + 33554432;
constexpr size_t OFF_Y   = OFF_P + (size_t)GT * NP1 * 2;
constexpr size_t OFF_V   = OFF_Y + (size_t)NTOK * YP * 2;
static_assert(OFF_STAT + (size_t)NTOK * 64 <= OFF_H, "ws map");

template <class T> __device__ __forceinline__ T* gptr(T* p) { typedef const __attribute__((address_space(0))) void* gvp; __builtin_assume(!__builtin_amdgcn_is_shared((gvp)p)); __builtin_assume(!__builtin_amdgcn_is_private((gvp)p)); return p; }
__device__ __forceinline__ unsigned f2bf(float f) { unsigned u = __builtin_bit_cast(unsigned, f); return (u + 0x7fffu + ((u >> 16) & 1u)) >> 16; }
typedef float f32x2_t __attribute__((ext_vector_type(2)));
typedef __bf16 bf16x2_t __attribute__((ext_vector_type(2)));
__device__ __forceinline__ unsigned pk2(float lo, float hi) { const f32x2_t v = {lo, hi}; const bf16x2_t b = __builtin_convertvector(v, bf16x2_t); return __builtin_bit_cast(unsigned, b); }
__device__ __forceinline__ float bflo(unsigned u) { return __builtin_bit_cast(float, u << 16); }
__device__ __forceinline__ float bfhi(unsigned u) { return __builtin_bit_cast(float, u & 0xffff0000u); }
__device__ __forceinline__ float silu(float z) { return z * __builtin_amdgcn_rcpf(1.f + __builtin_amdgcn_exp2f(-1.44269504089f * z)); }
__device__ __forceinline__ float wave_sum(float v) {
#pragma unroll
    for (int o = 1; o < 64; o <<= 1) v += __shfl_xor(v, o);
    return v;
}
#define LDS_WAIT() asm volatile("s_waitcnt lgkmcnt(0)" ::: "memory")
__device__ __forceinline__ void ld8(const bf16_t* p, float (&f)[8]) {
    const u32x4 v = *(const u32x4*)p;
    f[0] = bflo(v.x); f[1] = bfhi(v.x); f[2] = bflo(v.y); f[3] = bfhi(v.y); f[4] = bflo(v.z); f[5] = bfhi(v.z); f[6] = bflo(v.w); f[7] = bfhi(v.w);
}
__device__ __forceinline__ void st8(bf16_t* p, const float (&f)[8]) {
    u32x4 o; o.x = pk2(f[0], f[1]); o.y = pk2(f[2], f[3]); o.z = pk2(f[4], f[5]); o.w = pk2(f[6], f[7]);
    *(u32x4*)p = o;
}

namespace pg8 {
constexpr int BM = 256, BK = 64, HALF = 128, HTB = HALF * BK * 2, NXCD = 8, WGM = 8;
__device__ __forceinline__ int lds_byte(int r, int c) { const int st = (r >> 4) * 2 + (c >> 5), rr = r & 15, cc = c & 31, ob = rr * 64 + cc * 2; return st * 1024 + (ob ^ (((ob >> 9) & 1) << 5)); }
__device__ __forceinline__ void stage_rc(int b, int& R, int& C) { const int st = b / 1024, sb = b % 1024, swz = sb ^ (((sb >> 9) & 1) << 5); R = (st >> 1) * 16 + swz / 64; C = (st & 1) * 32 + (swz % 64) / 2; }
__device__ __forceinline__ int perm32(int rho) { const int n = rho >> 4, i = rho & 15; return 8 * (i >> 2) + 4 * n + (i & 3); }

struct Unit { int pm, pn, g; };
struct Gemm {
    const bf16_t* A; const bf16_t* Bt; int lda, ldb, K; long sA, sB;
    int nM, nN, nB;
    bf16_t* O; int ldc; long sO;
    int emode;
    const float* res; float* out;
    const bf16_t* resb; bf16_t* outb;
    float* stats_w;
    const float* stats_r;
    const float* res2; int split_pm;
};
struct Sched {
    int nM, nN, nwg, nB, G, c;
    __device__ __forceinline__ bool next(int i, Unit& u) const {
        const long L = (long)i * G + c; if (L >= (long)nwg * nB) return false;
        const int g = (int)(L / nwg); int wgid = (int)(L % nwg);
        { const int q = nwg / NXCD, r = nwg % NXCD, xcd = wgid % NXCD, off = wgid / NXCD; wgid = (xcd < r ? xcd * (q + 1) : r * (q + 1) + (xcd - r) * q) + off; }
        const int nig = WGM * nN, gid = wgid / nig, fm = gid * WGM, gsz = (nM - fm) < WGM ? (nM - fm) : WGM;
        u.pm = fm + ((wgid % nig) % gsz); u.pn = (wgid % nig) / gsz; u.g = g; return true;
    }
};
struct EpiBf16 {
    __device__ __forceinline__ void operator()(const Gemm& g, const f32x4 (&acc)[2][2][4][2], const Unit& u, int wr, int wc, int fr, int fq) const {
        const int row0 = u.pm * BM + wr * 64 + fr;
        bf16_t* base = g.O + (size_t)u.g * g.sO;
        int kind = 0, cb = u.pn * BM;
        if (g.emode == 1) { const int pn = u.pn; if (pn < 8) { kind = 2; cb = 128 * pn; } else if (pn < 16) { kind = 3; cb = 1024 + 128 * (pn - 8); } else if (pn < 20) { kind = 0; cb = 2048 + 256 * (pn - 16); } else { kind = 1; cb = 3072 + 256 * (pn - 20); } }
        else if (g.emode == 2) { const int pn = u.pn; if (pn < 8) { kind = 3; cb = 128 * pn; } else if (pn < 20) { kind = 0; cb = 1024 + 256 * (pn - 8); } else { kind = 1; cb = 4096 + 256 * (pn - 20); } }
        const int col0 = cb + wc * 32 + 8 * fq;
        float rscv[2][4];
#pragma unroll
        for (int ai = 0; ai < 2; ++ai)
#pragma unroll
            for (int m = 0; m < 4; ++m) rscv[ai][m] = 1.f;
        if (g.stats_r) {
            f32x4 sq[2][4];
#pragma unroll
            for (int ai = 0; ai < 2; ++ai)
#pragma unroll
                for (int m = 0; m < 4; ++m) sq[ai][m] = *(const f32x4*)(g.stats_r + (size_t)(row0 + ai * HALF + m * 16) * 16 + 4 * fq);
#pragma unroll
            for (int ai = 0; ai < 2; ++ai)
#pragma unroll
                for (int m = 0; m < 4; ++m) { float ss = (sq[ai][m].x + sq[ai][m].y) + (sq[ai][m].z + sq[ai][m].w);
                    ss += __shfl_xor(ss, 16); ss += __shfl_xor(ss, 32);
                    rscv[ai][m] = rsqrtf(ss * (1.f / 1024.f) + 1e-6f); }
        }
        if (kind >= 2) {
#pragma unroll
            for (int ai = 0; ai < 2; ++ai)
#pragma unroll
                for (int m = 0; m < 4; ++m) { bf16_t* rowp = base + (size_t)(row0 + ai * HALF + m * 16) * g.ldc + col0;
                    const float rsc = rscv[ai][m];
                    const f32x4 l0 = acc[ai][0][m][0] * rsc, l1 = acc[ai][0][m][1] * rsc; f32x4 h0 = acc[ai][1][m][0] * rsc, h1 = acc[ai][1][m][1] * rsc;
                    if (kind == 3) { h0 = (f32x4){silu(h0[0]), silu(h0[1]), silu(h0[2]), silu(h0[3])}; h1 = (f32x4){silu(h1[0]), silu(h1[1]), silu(h1[2]), silu(h1[3])}; }
                    const f32x4 v0 = l0 * h0, v1 = l1 * h1;
                    u32x4 w; w.x = pk2(v0[0], v0[1]); w.y = pk2(v0[2], v0[3]); w.z = pk2(v1[0], v1[1]); w.w = pk2(v1[2], v1[3]);
                    *(u32x4*)rowp = w; }
        } else {
#pragma unroll
            for (int ai = 0; ai < 2; ++ai)
#pragma unroll
                for (int m = 0; m < 4; ++m) { bf16_t* rowp = base + (size_t)(row0 + ai * HALF + m * 16) * g.ldc + col0;
#pragma unroll
                    for (int bj = 0; bj < 2; ++bj) { f32x4 v0 = acc[ai][bj][m][0] * rscv[ai][m], v1 = acc[ai][bj][m][1] * rscv[ai][m];
                        if (kind == 1) { v0 = (f32x4){silu(v0[0]), silu(v0[1]), silu(v0[2]), silu(v0[3])}; v1 = (f32x4){silu(v1[0]), silu(v1[1]), silu(v1[2]), silu(v1[3])}; }
                        u32x4 w; w.x = pk2(v0[0], v0[1]); w.y = pk2(v0[2], v0[3]); w.z = pk2(v1[0], v1[1]); w.w = pk2(v1[2], v1[3]);
                        *(u32x4*)(rowp + bj * HALF) = w; } }
        }
    }
};
struct EpiRes {
    __device__ __forceinline__ void operator()(const Gemm& g, const f32x4 (&acc)[2][2][4][2], const Unit& u, int wr, int wc, int fr, int fq) const {
        const int row0 = u.pm * BM + wr * 64 + fr, col0 = u.pn * BM + wc * 32 + 8 * fq;
        const float* resp = (u.pm >= g.split_pm) ? g.res2 : g.res;
#pragma unroll
        for (int ai = 0; ai < 2; ++ai)
#pragma unroll
            for (int m = 0; m < 4; ++m) { const size_t ro = (size_t)(row0 + ai * HALF + m * 16) * g.ldc + col0;
                float ssq = 0.f;
#pragma unroll
                for (int bj = 0; bj < 2; ++bj) {
                    f32x4 r0, r1;
                    if (g.resb) { const u32x4 rv = *(const u32x4*)(g.resb + ro + bj * HALF);
                        r0 = (f32x4){bflo(rv.x), bfhi(rv.x), bflo(rv.y), bfhi(rv.y)}; r1 = (f32x4){bflo(rv.z), bfhi(rv.z), bflo(rv.w), bfhi(rv.w)}; }
                    else { r0 = *(const f32x4*)(resp + ro + bj * HALF); r1 = *(const f32x4*)(resp + ro + bj * HALF + 4); }
                    const f32x4 x0 = r0 + acc[ai][bj][m][0], x1 = r1 + acc[ai][bj][m][1];
                    ssq += ((x0[0] * x0[0] + x0[1] * x0[1]) + (x0[2] * x0[2] + x0[3] * x0[3])) + ((x1[0] * x1[0] + x1[1] * x1[1]) + (x1[2] * x1[2] + x1[3] * x1[3]));
                    u32x4 w; w.x = pk2(x0[0], x0[1]); w.y = pk2(x0[2], x0[3]); w.z = pk2(x1[0], x1[1]); w.w = pk2(x1[2], x1[3]);
                    *(u32x4*)(g.outb + ro + bj * HALF) = w; }
                if (g.stats_w) { ssq += __shfl_xor(ssq, 16); ssq += __shfl_xor(ssq, 32);
                    if (fq == 0) g.stats_w[(size_t)(row0 + ai * HALF + m * 16) * 16 + u.pn * 4 + wc] = ssq; } }
    }
};

template <class Epi>
__device__ __forceinline__ void gemm_phase(LAS unsigned char* lds, const Gemm& g, const Sched& S, const Epi& E, const int tid) {
    const int wid = __builtin_amdgcn_readfirstlane(tid >> 6), lane = tid & 63, wr = wid >> 2, wc = wid & 3, fr = lane & 15, fq = lane >> 4;
    const int K = g.K, nt = K / BK;
    unsigned voffA[2], voffB[2];
#pragma unroll
    for (int i = 0; i < 2; ++i) { int R, C; stage_rc(tid * 16 + i * 8192, R, C); const int Rb = (R & ~31) + perm32(R & 31);
        voffA[i] = (unsigned)(R * g.lda + C) * 2u; voffB[i] = (unsigned)(Rb * g.ldb + C) * 2u; }
    const size_t kstep = (size_t)(BK * 2);
    const size_t hstepA = (size_t)HALF * g.lda * 2, hstepB = (size_t)HALF * g.ldb * 2;
    const unsigned ldsw = (unsigned)wid * 1024u;
    const int aoff = lds_byte(wr * 64 + fr, fq * 8), boff = lds_byte(wc * 32 + fr, fq * 8);
#define PG8_SA(b, h) (((b) * 2 + (h)) * HTB)
#define PG8_SB(b, h) ((4 + (b) * 2 + (h)) * HTB)
#define PG8_STAGE(bufoff, gbase, voff) do { _Pragma("unroll") for (int _i = 0; _i < 2; ++_i) \
        __builtin_amdgcn_global_load_lds((const unsigned*)((const char*)(gbase) + (voff)[_i]), (LAS unsigned*)(lds + (bufoff) + ldsw + _i * 8192), 16, 0, 0); } while (0)
#define PG8_LDA(dst, b, h) do { _Pragma("unroll") for (int m = 0; m < 4; ++m) _Pragma("unroll") for (int k = 0; k < 2; ++k) dst[m][k] = *(const LAS bf16x8*)(lds + PG8_SA(b, h) + aoff + m * 2048 + k * 1024); } while (0)
#define PG8_LDB(dst, b, h) do { _Pragma("unroll") for (int n = 0; n < 2; ++n) _Pragma("unroll") for (int k = 0; k < 2; ++k) dst[n][k] = *(const LAS bf16x8*)(lds + PG8_SB(b, h) + boff + n * 2048 + k * 1024); } while (0)
#define PG8_MMA(ai, bj, At, Bt) do { __builtin_amdgcn_s_setprio(1); _Pragma("unroll") for (int m = 0; m < 4; ++m) _Pragma("unroll") for (int n = 0; n < 2; ++n) _Pragma("unroll") for (int k = 0; k < 2; ++k) \
        acc[ai][bj][m][n] = __builtin_amdgcn_mfma_f32_16x16x32_bf16(Bt[n][k], At[m][k], acc[ai][bj][m][n], 0, 0, 0); __builtin_amdgcn_s_setprio(0); } while (0)
#define PG8_WAIT_V(n) asm volatile("s_waitcnt vmcnt(" #n ")" ::: "memory")
#define PG8_WAIT_L(n) asm volatile("s_waitcnt lgkmcnt(" #n ")" ::: "memory")
#define PG8_BAR __builtin_amdgcn_s_barrier()
#define PG8_SCHED __builtin_amdgcn_sched_barrier(0)
#define PG8_APTR(u) ((const char*)(g.A + (size_t)(u).g * g.sA) + (size_t)(u).pm * 2 * hstepA)
#define PG8_BPTR(u) ((const char*)(g.Bt + (size_t)(u).g * g.sB) + (size_t)(u).pn * 2 * hstepB)
    Unit cur, nxt; int ui = 0;
    if (!S.next(0, cur)) return;
    f32x4 acc[2][2][4][2];
    float zf = 0.f; asm volatile("" : "+v"(zf));
#pragma unroll
    for (int a = 0; a < 2; ++a)
#pragma unroll
        for (int b = 0; b < 2; ++b)
#pragma unroll
            for (int m = 0; m < 4; ++m)
#pragma unroll
                for (int n = 0; n < 2; ++n) acc[a][b][m][n] = (f32x4){zf, zf, zf, zf};
    bf16x8 At[4][2], B0[2][2], B1[2][2];
    const char* cA = PG8_APTR(cur); const char* cB = PG8_BPTR(cur);
    PG8_STAGE(PG8_SB(0, 0), cB, voffB); PG8_STAGE(PG8_SB(0, 1), cB + hstepB, voffB); PG8_STAGE(PG8_SA(0, 0), cA, voffA); PG8_STAGE(PG8_SA(0, 1), cA + hstepA, voffA);
    if (wr == 1) PG8_BAR;
    PG8_WAIT_V(2); PG8_BAR;
    PG8_STAGE(PG8_SB(1, 0), cB + kstep, voffB); PG8_STAGE(PG8_SA(1, 0), cA + kstep, voffA); PG8_STAGE(PG8_SB(1, 1), cB + hstepB + kstep, voffB);
    PG8_WAIT_V(6); PG8_BAR;
    for (;;) {
        const bool has_next = S.next(ui + 1, nxt);
        const char* nA = has_next ? PG8_APTR(nxt) : cA; const char* nB = has_next ? PG8_BPTR(nxt) : cB;
        for (int t = 0; t < nt; t += 2) {
            const bool last = (t == nt - 2);
            const char* a1 = cA + (size_t)(t + 1) * kstep;
            const char* a2 = last ? nA : cA + (size_t)(t + 2) * kstep; const char* b2 = last ? nB : cB + (size_t)(t + 2) * kstep;
            const char* a3 = a2 + kstep; const char* b3 = b2 + kstep;
            PG8_LDB(B0, 0, 0); PG8_LDB(B1, 0, 1); PG8_SCHED; PG8_LDA(At, 0, 0); PG8_STAGE(PG8_SA(1, 1), a1 + hstepA, voffA);
            PG8_WAIT_V(8); PG8_WAIT_L(0); PG8_BAR; PG8_MMA(0, 0, At, B0); PG8_MMA(0, 1, At, B1); PG8_BAR; PG8_SCHED;
            PG8_LDA(At, 0, 1); PG8_STAGE(PG8_SB(0, 0), b2, voffB); PG8_STAGE(PG8_SB(0, 1), b2 + hstepB, voffB); PG8_STAGE(PG8_SA(0, 0), a2, voffA);
            PG8_WAIT_V(8); PG8_WAIT_L(0); PG8_BAR; PG8_MMA(1, 0, At, B0); PG8_MMA(1, 1, At, B1); PG8_BAR; PG8_SCHED;
            PG8_LDB(B0, 1, 0); PG8_LDB(B1, 1, 1); PG8_SCHED; PG8_LDA(At, 1, 0); PG8_STAGE(PG8_SA(0, 1), a2 + hstepA, voffA);
            PG8_WAIT_V(8); PG8_WAIT_L(0); PG8_BAR; PG8_MMA(0, 0, At, B0); PG8_MMA(0, 1, At, B1); PG8_BAR; PG8_SCHED;
            PG8_LDA(At, 1, 1); PG8_STAGE(PG8_SB(1, 0), b3, voffB); PG8_STAGE(PG8_SB(1, 1), b3 + hstepB, voffB); PG8_STAGE(PG8_SA(1, 0), a3, voffA);
            PG8_WAIT_V(8); PG8_WAIT_L(0); PG8_BAR; PG8_MMA(1, 0, At, B0); PG8_MMA(1, 1, At, B1); PG8_BAR; PG8_SCHED;
        }
        if (wr == 0) PG8_BAR;
        E(g, acc, cur, wr, wc, fr, fq);
        if (!has_next) break;
#pragma unroll
        for (int a = 0; a < 2; ++a)
#pragma unroll
            for (int b = 0; b < 2; ++b)
#pragma unroll
                for (int m = 0; m < 4; ++m)
#pragma unroll
                    for (int n = 0; n < 2; ++n) acc[a][b][m][n] = (f32x4){zf, zf, zf, zf};
        cur = nxt; cA = nA; cB = nB; ++ui;
        if (wr == 1) PG8_BAR;
    }
    PG8_WAIT_V(0);
    PG8_BAR;
#undef PG8_SA
#undef PG8_SB
#undef PG8_STAGE
#undef PG8_LDA
#undef PG8_LDB
#undef PG8_MMA
#undef PG8_WAIT_V
#undef PG8_WAIT_L
#undef PG8_BAR
#undef PG8_SCHED
#undef PG8_APTR
#undef PG8_BPTR
}
}

#define XB_TMO      128
#define XB_XCNT(j)  (256  + 64 * (j))
#define XB_XSUB(j)  (1280 + 64 * (j))
#define XB_XGEN(j)  (2304 + 64 * (j))
#define XB_TOP      3328
#define XB_TOPGEN   3392
#define XCD_BAR_WORDS 3456
#define XB_SPIN_CAP (1u << 18)

__device__ __forceinline__ unsigned xb_ld(unsigned* p)              { return __hip_atomic_load(p, __ATOMIC_RELAXED, __HIP_MEMORY_SCOPE_AGENT); }
__device__ __forceinline__ unsigned xb_add(unsigned* p, unsigned v) { return __hip_atomic_fetch_add(p, v, __ATOMIC_RELAXED, __HIP_MEMORY_SCOPE_AGENT); }
__device__ __forceinline__ unsigned xb_xcc_id() { return (unsigned)__builtin_amdgcn_s_getreg((3 << 11) | 20) & 0xFu; }
#define XB_SPIN(cond, bar) do { unsigned _sp = 0; while (cond) { __builtin_amdgcn_s_sleep(1); \
    if ((++_sp & 255u) == 0u) { if (xb_ld(&(bar)[XB_TMO])) break; if (_sp > XB_SPIN_CAP) { atomicAdd(&(bar)[XB_TMO], 1u); break; } } } } while (0)

struct XcdBarrier {
    unsigned* bar; unsigned x;
    volatile LAS unsigned* st;
};

__device__ __forceinline__ XcdBarrier xcd_barrier_post(unsigned* bar, volatile LAS unsigned* st) {
    XcdBarrier b; b.bar = bar; b.x = xb_xcc_id(); b.st = st;
    if (threadIdx.x == 0) (void)xb_add(&bar[XB_XCNT(b.x)], 1u);
    return b;
}
__device__ __forceinline__ void xcd_barrier_complete(unsigned* bar, unsigned x, unsigned& nloc, unsigned& nx) {
    const unsigned G = gridDim.x * gridDim.y * gridDim.z;
    unsigned sum, cnt, mine, sp = 0u;
    for (;;) {
        sum = 0u; cnt = 0u; mine = 0u;
#pragma unroll
        for (unsigned j = 0; j < 16; ++j) { const unsigned c = xb_ld(&bar[XB_XCNT(j)]); sum += c; cnt += (c > 0u) ? 1u : 0u; mine = (j == x) ? c : mine; }
        if (sum == G) break;
        __builtin_amdgcn_s_sleep(1);
        if ((++sp & 255u) == 0u) { if (xb_ld(&bar[XB_TMO])) break; if (sp > XB_SPIN_CAP) { atomicAdd(&bar[XB_TMO], 1u); break; } }
    }
    nloc = mine > 0u ? mine : 1u; nx = cnt > 0u ? cnt : 1u;
}

__device__ __forceinline__ void xcd_barrier(const XcdBarrier& b) {
    asm volatile("s_waitcnt vmcnt(0)" ::: "memory");
    __syncthreads();
    if (threadIdx.x == 0) {
        unsigned* bar = b.bar;
        __builtin_amdgcn_s_waitcnt(0);
        unsigned nloc = b.st[0], nx = b.st[1];
        if (nloc == 0u) { xcd_barrier_complete(bar, b.x, nloc, nx); b.st[0] = nloc; b.st[1] = nx; }
        const unsigned old = xb_add(&bar[XB_XSUB(b.x)], 1u);
        const unsigned gen = old / nloc;
        if (old + 1u == (gen + 1u) * nloc) {
            __builtin_amdgcn_fence(__ATOMIC_RELEASE, "agent");
            asm volatile("s_waitcnt vmcnt(0)" ::: "memory");
            const unsigned og = xb_add(&bar[XB_TOP], 1u);
            const unsigned tg = og / nx;
            if (og + 1u == (tg + 1u) * nx) xb_add(&bar[XB_TOPGEN], 1u);
            else XB_SPIN(xb_ld(&bar[XB_TOPGEN]) == tg, bar);
            __builtin_amdgcn_fence(__ATOMIC_ACQUIRE, "agent");
            xb_add(&bar[XB_XGEN(b.x)], 1u);
            asm volatile("s_waitcnt vmcnt(0)" ::: "memory");
        } else {
            XB_SPIN(xb_ld(&bar[XB_XGEN(b.x)]) == gen, bar);
            __builtin_amdgcn_fence(__ATOMIC_ACQUIRE, "agent");
            asm volatile("s_waitcnt vmcnt(0)" ::: "memory");
        }
    }
    __syncthreads();
}


struct Args { const float* in[15]; float* out; unsigned char* ws; int ph_lo, ph_hi; };
enum { I_XP = 0, I_XS, I_NORMG, I_EWIN, I_ECONV, I_EPOOLW, I_EPOOLS, I_EWOUT, I_OWIN, I_OSGUG, I_OSGUW, I_OSGUB, I_OFNET, I_OWOUT, I_FINALG };
constexpr int NPHASES = 20;

__device__ __forceinline__ void transpose_item(const float* W, int ldw, int ncols, bf16_t* WT, int ldt, const float* cscale, LAS float* scr, int item, int lane, int pmode = 0, const float* kscale = nullptr) {
    const int nblk = ncols / 32, kb = item / nblk, nb = item % nblk, k0 = 64 * kb, n0 = 32 * nb;
    int d0 = n0;
    { const int seg = n0 >> 10, ch0 = n0 & 1023, pr = 256 * (ch0 >> 7) + (ch0 & 127);
      if (pmode == 1) d0 = ((seg & 1) ? 2048 : 0) + ((seg & 2) ? 128 : 0) + pr;
      else if (pmode == 2) d0 = (seg == 1) ? 2048 + ch0 : ((seg == 2) ? 128 : 0) + pr; }
    const float sc = cscale ? cscale[n0 + (lane & 31)] : 1.f;
#pragma unroll 8
    for (int i = 0; i < 32; ++i) { const int kk = 2 * i + (lane >> 5); scr[kk * 33 + (lane & 31)] = W[(size_t)(k0 + kk) * ldw + n0 + (lane & 31)] * (kscale ? sc * kscale[k0 + kk] : sc); }
    LDS_WAIT();
    const int c = lane & 7;
#pragma unroll
    for (int j = 0; j < 4; ++j) { const int n = (lane >> 3) + 8 * j; const LAS float* s = scr + (8 * c) * 33 + n;
        u32x4 o; o.x = pk2(s[0 * 33], s[1 * 33]); o.y = pk2(s[2 * 33], s[3 * 33]); o.z = pk2(s[4 * 33], s[5 * 33]); o.w = pk2(s[6 * 33], s[7 * 33]);
        *(u32x4*)(WT + (size_t)(d0 + n) * ldt + k0 + 8 * c) = o; }
    LDS_WAIT();
}
__device__ __forceinline__ void rms_row_bf16(const float* xrow, const float* gain, bf16_t* orow, int lane) {
    const f32x4* xr = (const f32x4*)xrow + lane; const f32x4* gr = (const f32x4*)gain + lane;
    f32x4 v[4]; float s = 0.f;
#pragma unroll
    for (int j = 0; j < 4; ++j) { v[j] = xr[64 * j]; s += (v[j].x * v[j].x + v[j].y * v[j].y) + (v[j].z * v[j].z + v[j].w * v[j].w); }
    const float r = rsqrtf(wave_sum(s) * (1.f / D) + EPS);
    u32x2* o8 = (u32x2*)orow + lane;
#pragma unroll
    for (int j = 0; j < 4; ++j) { const f32x4 gg = gr[64 * j]; u32x2 o; o.x = pk2(v[j].x * r * gg.x, v[j].y * r * gg.y); o.y = pk2(v[j].z * r * gg.z, v[j].w * r * gg.w); o8[64 * j] = o; }
}
__device__ __forceinline__ void rms_row_f32_inplace(float* xrow, const float* gain, int lane) {
    f32x4* xr = (f32x4*)xrow + lane; const f32x4* gr = (const f32x4*)gain + lane;
    f32x4 v[4]; float s = 0.f;
#pragma unroll
    for (int j = 0; j < 4; ++j) { v[j] = xr[64 * j]; s += (v[j].x * v[j].x + v[j].y * v[j].y) + (v[j].z * v[j].z + v[j].w * v[j].w); }
    const float r = rsqrtf(wave_sum(s) * (1.f / D) + EPS);
#pragma unroll
    for (int j = 0; j < 4; ++j) { const f32x4 gg = gr[64 * j]; xr[64 * j] = v[j] * r * gg; }
}
__device__ __forceinline__ void cvt8(const float* src, bf16_t* dst) {
    const f32x4 a = *(const f32x4*)src, b = *(const f32x4*)(src + 4);
    u32x4 o; o.x = pk2(a.x, a.y); o.y = pk2(a.z, a.w); o.z = pk2(b.x, b.y); o.w = pk2(b.z, b.w);
    *(u32x4*)dst = o;
}


__device__ __forceinline__ void cvt8u(const u32x4 v, float (&f)[8]) {
    f[0] = bflo(v.x); f[1] = bfhi(v.x); f[2] = bflo(v.y); f[3] = bfhi(v.y); f[4] = bflo(v.z); f[5] = bfhi(v.z); f[6] = bflo(v.w); f[7] = bfhi(v.w);
}
template <int HW>
__device__ __forceinline__ void pool_item(const bf16_t* P, bf16_t* Y, int r0, int c, int S) {
    constexpr int NR = 8 + 2 * HW;
    const int s0 = r0 & (S - 1);
    const bf16_t* base = P + (size_t)r0 * NP0 + 2048 + c;
    u32x4 raw[NR], zr[8];
#pragma unroll
    for (int j = 0; j < NR; ++j) { const int t = s0 - HW + j; raw[j] = (t >= 0 && t < S) ? *(const u32x4*)(base + (ptrdiff_t)(j - HW) * NP0) : (u32x4){0u, 0u, 0u, 0u}; }
#pragma unroll
    for (int i = 0; i < 8; ++i) zr[i] = *(const u32x4*)(base + (size_t)i * NP0 + 1024);
    float sum[8];
#pragma unroll
    for (int e = 0; e < 8; ++e) sum[e] = 0.f;
#pragma unroll
    for (int j = 0; j < 2 * HW; ++j) { float v[8]; cvt8u(raw[j], v);
#pragma unroll
        for (int e = 0; e < 8; ++e) sum[e] += v[e]; }
#pragma unroll
    for (int i = 0; i < 8; ++i) {
        const int lo = max(s0 + i - HW, 0), hi = min(s0 + i + HW, S);
        const float inv = 1.f / (float)(hi - lo);
        float v[8], z[8], o[8]; cvt8u(raw[i + HW], v); cvt8u(zr[i], z);
#pragma unroll
        for (int e = 0; e < 8; ++e) o[e] = (sum[e] * inv - v[e]) * z[e];
        st8(Y + (size_t)(r0 + i) * YP + 1024 + c, o);
        if (i < 7) { float a[8], b[8]; cvt8u(raw[i + 2 * HW], a); cvt8u(raw[i], b);
#pragma unroll
            for (int e = 0; e < 8; ++e) sum[e] += a[e] - b[e]; }
    }
}
__device__ __forceinline__ void conv_item(const bf16_t* P, bf16_t* Y, const float* convw, int r0, int c, int S) {
    const int s0 = r0 & (S - 1);
    const bf16_t* base = P + (size_t)r0 * NP0 + c;
    u32x4 ur[10], gr[8];
#pragma unroll
    for (int j = 0; j < 10; ++j) { const int t = s0 - 1 + j; ur[j] = (t >= 0 && t < S) ? *(const u32x4*)(base + (ptrdiff_t)(j - 1) * NP0) : (u32x4){0u, 0u, 0u, 0u}; }
#pragma unroll
    for (int i = 0; i < 8; ++i) gr[i] = *(const u32x4*)(base + (size_t)i * NP0 + 1024);
    float w[3][8];
#pragma unroll
    for (int k = 0; k < 3; ++k) { const f32x4 w0 = *(const f32x4*)(convw + k * 1024 + c), w1 = *(const f32x4*)(convw + k * 1024 + c + 4);
        w[k][0] = w0.x; w[k][1] = w0.y; w[k][2] = w0.z; w[k][3] = w0.w; w[k][4] = w1.x; w[k][5] = w1.y; w[k][6] = w1.z; w[k][7] = w1.w; }
    float u0[8], u1[8], u2[8];
    cvt8u(ur[0], u0); cvt8u(ur[1], u1);
#pragma unroll
    for (int i = 0; i < 8; ++i) {
        float gt[8], o[8]; cvt8u(ur[i + 2], u2); cvt8u(gr[i], gt);
#pragma unroll
        for (int e = 0; e < 8; ++e) { const float y = w[0][e] * u0[e] + w[1][e] * u1[e] + w[2][e] * u2[e]; o[e] = gt[e] * y; u0[e] = u1[e]; u1[e] = u2[e]; }
        st8(Y + (size_t)(r0 + i) * YP + c, o);
    }
}
template <int NR>
__device__ __forceinline__ void rms_rowsN_bf16(const float* x, const float* gain, bf16_t* o, int lane) {
    f32x4 v[NR][4]; float s[NR];
#pragma unroll
    for (int r = 0; r < NR; ++r)
#pragma unroll
        for (int j = 0; j < 4; ++j) v[r][j] = ((const f32x4*)(x + (size_t)r * D))[lane + 64 * j];
#pragma unroll
    for (int r = 0; r < NR; ++r) { s[r] = 0.f;
#pragma unroll
        for (int j = 0; j < 4; ++j) s[r] += (v[r][j].x * v[r][j].x + v[r][j].y * v[r][j].y) + (v[r][j].z * v[r][j].z + v[r][j].w * v[r][j].w); }
#pragma unroll
    for (int of = 1; of < 64; of <<= 1)
#pragma unroll
        for (int r = 0; r < NR; ++r) s[r] += __shfl_xor(s[r], of);
#pragma unroll
    for (int j = 0; j < 4; ++j) { const f32x4 gg = ((const f32x4*)gain)[lane + 64 * j];
#pragma unroll
        for (int r = 0; r < NR; ++r) { const float rs = rsqrtf(s[r] * (1.f / D) + EPS); u32x2 a;
            a.x = pk2(v[r][j].x * rs * gg.x, v[r][j].y * rs * gg.y); a.y = pk2(v[r][j].z * rs * gg.z, v[r][j].w * rs * gg.w);
            ((u32x2*)(o + (size_t)r * D))[lane + 64 * j] = a; } }
}
template <int NR>
__device__ __forceinline__ void rms_rowsN_bf16_to_f32(const bf16_t* x, const float* gain, float* o, int lane) {
    u32x4 raw[NR][2]; float s[NR];
#pragma unroll
    for (int r = 0; r < NR; ++r)
#pragma unroll
        for (int j = 0; j < 2; ++j) raw[r][j] = *(const u32x4*)(x + (size_t)r * D + 512 * j + 8 * lane);
#pragma unroll
    for (int r = 0; r < NR; ++r) { s[r] = 0.f;
#pragma unroll
        for (int j = 0; j < 2; ++j) { float v[8]; cvt8u(raw[r][j], v);
#pragma unroll
            for (int e = 0; e < 8; ++e) s[r] += v[e] * v[e]; } }
#pragma unroll
    for (int of = 1; of < 64; of <<= 1)
#pragma unroll
        for (int r = 0; r < NR; ++r) s[r] += __shfl_xor(s[r], of);
#pragma unroll
    for (int j = 0; j < 2; ++j) { const f32x4 g0 = *(const f32x4*)(gain + 512 * j + 8 * lane), g1 = *(const f32x4*)(gain + 512 * j + 8 * lane + 4);
#pragma unroll
        for (int r = 0; r < NR; ++r) { const float rs = rsqrtf(s[r] * (1.f / D) + EPS); float v[8]; cvt8u(raw[r][j], v);
            float* op = o + (size_t)r * D + 512 * j + 8 * lane;
            *(f32x4*)op = (f32x4){v[0] * rs * g0.x, v[1] * rs * g0.y, v[2] * rs * g0.z, v[3] * rs * g0.w};
            *(f32x4*)(op + 4) = (f32x4){v[4] * rs * g1.x, v[5] * rs * g1.y, v[6] * rs * g1.z, v[7] * rs * g1.w}; } }
}
__device__ __forceinline__ void rms_rows2_bf16(const float* x0, const float* x1, const float* gain, bf16_t* o0, bf16_t* o1, int lane) {
    const f32x4* xr0 = (const f32x4*)x0 + lane; const f32x4* xr1 = (const f32x4*)x1 + lane; const f32x4* gr = (const f32x4*)gain + lane;
    f32x4 v[4], w[4]; float s = 0.f, t = 0.f;
#pragma unroll
    for (int j = 0; j < 4; ++j) { v[j] = xr0[64 * j]; w[j] = xr1[64 * j]; }
#pragma unroll
    for (int j = 0; j < 4; ++j) { s += (v[j].x * v[j].x + v[j].y * v[j].y) + (v[j].z * v[j].z + v[j].w * v[j].w); t += (w[j].x * w[j].x + w[j].y * w[j].y) + (w[j].z * w[j].z + w[j].w * w[j].w); }
#pragma unroll
    for (int o = 1; o < 64; o <<= 1) { s += __shfl_xor(s, o); t += __shfl_xor(t, o); }
    const float r = rsqrtf(s * (1.f / D) + EPS), q = rsqrtf(t * (1.f / D) + EPS);
    u32x2* p0 = (u32x2*)o0 + lane; u32x2* p1 = (u32x2*)o1 + lane;
#pragma unroll
    for (int j = 0; j < 4; ++j) { const f32x4 gg = gr[64 * j]; u32x2 a, b;
        a.x = pk2(v[j].x * r * gg.x, v[j].y * r * gg.y); a.y = pk2(v[j].z * r * gg.z, v[j].w * r * gg.w);
        b.x = pk2(w[j].x * q * gg.x, w[j].y * q * gg.y); b.y = pk2(w[j].z * q * gg.z, w[j].w * q * gg.w);
        p0[64 * j] = a; p1[64 * j] = b; }
}
__device__ __forceinline__ void rms_rows2_bf16_in(const bf16_t* x0, const bf16_t* x1, const float* gain, bf16_t* o0, bf16_t* o1, int lane) {
    float v[2][8], w[2][8]; float s = 0.f, t = 0.f;
#pragma unroll
    for (int j = 0; j < 2; ++j) { ld8(x0 + 512 * j + 8 * lane, v[j]); ld8(x1 + 512 * j + 8 * lane, w[j]); }
#pragma unroll
    for (int j = 0; j < 2; ++j)
#pragma unroll
        for (int e = 0; e < 8; ++e) { s += v[j][e] * v[j][e]; t += w[j][e] * w[j][e]; }
#pragma unroll
    for (int o = 1; o < 64; o <<= 1) { s += __shfl_xor(s, o); t += __shfl_xor(t, o); }
    const float r = rsqrtf(s * (1.f / D) + EPS), q = rsqrtf(t * (1.f / D) + EPS);
#pragma unroll
    for (int j = 0; j < 2; ++j) { const f32x4 g0 = *(const f32x4*)(gain + 512 * j + 8 * lane), g1 = *(const f32x4*)(gain + 512 * j + 8 * lane + 4);
        float a[8], b[8];
        a[0] = v[j][0] * r * g0.x; a[1] = v[j][1] * r * g0.y; a[2] = v[j][2] * r * g0.z; a[3] = v[j][3] * r * g0.w; a[4] = v[j][4] * r * g1.x; a[5] = v[j][5] * r * g1.y; a[6] = v[j][6] * r * g1.z; a[7] = v[j][7] * r * g1.w;
        b[0] = w[j][0] * q * g0.x; b[1] = w[j][1] * q * g0.y; b[2] = w[j][2] * q * g0.z; b[3] = w[j][3] * q * g0.w; b[4] = w[j][4] * q * g1.x; b[5] = w[j][5] * q * g1.y; b[6] = w[j][6] * q * g1.z; b[7] = w[j][7] * q * g1.w;
        st8(o0 + 512 * j + 8 * lane, a); st8(o1 + 512 * j + 8 * lane, b); }
}
__device__ __forceinline__ void rms_rows2_bf16_to_f32(const bf16_t* x0, const bf16_t* x1, const float* gain, float* o0, float* o1, int lane) {
    float v[2][8], w[2][8]; float s = 0.f, t = 0.f;
#pragma unroll
    for (int j = 0; j < 2; ++j) { ld8(x0 + 512 * j + 8 * lane, v[j]); ld8(x1 + 512 * j + 8 * lane, w[j]); }
#pragma unroll
    for (int j = 0; j < 2; ++j)
#pragma unroll
        for (int e = 0; e < 8; ++e) { s += v[j][e] * v[j][e]; t += w[j][e] * w[j][e]; }
#pragma unroll
    for (int o = 1; o < 64; o <<= 1) { s += __shfl_xor(s, o); t += __shfl_xor(t, o); }
    const float r = rsqrtf(s * (1.f / D) + EPS), q = rsqrtf(t * (1.f / D) + EPS);
#pragma unroll
    for (int j = 0; j < 2; ++j) { const f32x4 g0 = *(const f32x4*)(gain + 512 * j + 8 * lane), g1 = *(const f32x4*)(gain + 512 * j + 8 * lane + 4);
        *(f32x4*)(o0 + 512 * j + 8 * lane) = (f32x4){v[j][0] * r * g0.x, v[j][1] * r * g0.y, v[j][2] * r * g0.z, v[j][3] * r * g0.w};
        *(f32x4*)(o0 + 512 * j + 8 * lane + 4) = (f32x4){v[j][4] * r * g1.x, v[j][5] * r * g1.y, v[j][6] * r * g1.z, v[j][7] * r * g1.w};
        *(f32x4*)(o1 + 512 * j + 8 * lane) = (f32x4){w[j][0] * q * g0.x, w[j][1] * q * g0.y, w[j][2] * q * g0.z, w[j][3] * q * g0.w};
        *(f32x4*)(o1 + 512 * j + 8 * lane + 4) = (f32x4){w[j][4] * q * g1.x, w[j][5] * q * g1.y, w[j][6] * q * g1.z, w[j][7] * q * g1.w}; }
}
__device__ __forceinline__ void rms_rows2_f32_inplace(float* x0, float* x1, const float* gain, int lane) {
    f32x4* xr0 = (f32x4*)x0 + lane; f32x4* xr1 = (f32x4*)x1 + lane; const f32x4* gr = (const f32x4*)gain + lane;
    f32x4 v[4], w[4]; float s = 0.f, t = 0.f;
#pragma unroll
    for (int j = 0; j < 4; ++j) { v[j] = xr0[64 * j]; w[j] = xr1[64 * j]; }
#pragma unroll
    for (int j = 0; j < 4; ++j) { s += (v[j].x * v[j].x + v[j].y * v[j].y) + (v[j].z * v[j].z + v[j].w * v[j].w); t += (w[j].x * w[j].x + w[j].y * w[j].y) + (w[j].z * w[j].z + w[j].w * w[j].w); }
#pragma unroll
    for (int o = 1; o < 64; o <<= 1) { s += __shfl_xor(s, o); t += __shfl_xor(t, o); }
    const float r = rsqrtf(s * (1.f / D) + EPS), q = rsqrtf(t * (1.f / D) + EPS);
#pragma unroll
    for (int j = 0; j < 4; ++j) { const f32x4 gg = gr[64 * j]; xr0[64 * j] = v[j] * r * gg; xr1[64 * j] = w[j] * q * gg; }
}

typedef short v4i16_t __attribute__((ext_vector_type(4)));
template <int KS>
__device__ __forceinline__ void seqmix_load_w(bf16x8 (&w)[KS], const bf16_t* Wrow  ) {
#pragma unroll
    for (int ks = 0; ks < KS; ++ks) {
        const u32x2 w0 = *(const u32x2*)(Wrow + 32 * ks), w1 = *(const u32x2*)(Wrow + 32 * ks + 16);
        const u32x4 wv = (u32x4){w0.x, w0.y, w1.x, w1.y};
        w[ks] = __builtin_bit_cast(bf16x8, wv);
    }
}
template <int NCT>
__device__ __forceinline__ void seqmix_load_dstep(bf16x8 (&d)[NCT], const LAS bf16_t* rb  , int RS) {
#pragma unroll
    for (int i = 0; i < NCT; ++i) {
        const v4i16_t d0 = __builtin_amdgcn_ds_read_tr16_b64_v4i16((LAS v4i16_t*)(rb + 16 * i));
        const v4i16_t d1 = __builtin_amdgcn_ds_read_tr16_b64_v4i16((LAS v4i16_t*)(rb + 16 * RS + 16 * i));
        d[i] = (bf16x8){d0[0], d0[1], d0[2], d0[3], d1[0], d1[1], d1[2], d1[3]};
    }
}
template <int KS, int NCT>
__device__ __forceinline__ void seqmix_mma_tr(f32x4 (&acc)[NCT], const LAS bf16_t* R, int RS, int ct0, const bf16x8 (&w)[KS], int lane) {
    const int g = lane >> 4, li = lane & 15;
    const LAS bf16_t* rbase = R + (4 * g + (li >> 2)) * RS + 16 * ct0 + 4 * (li & 3);
    bf16x8 d[2][NCT];
    seqmix_load_dstep<NCT>(d[0], rbase, RS);
#pragma unroll
    for (int ks = 0; ks < KS; ++ks) {
        if (ks + 1 < KS) seqmix_load_dstep<NCT>(d[(ks + 1) & 1], rbase + 32 * (ks + 1) * RS, RS);
        __builtin_amdgcn_sched_barrier(0);
#pragma unroll
        for (int i = 0; i < NCT; ++i) acc[i] = __builtin_amdgcn_mfma_f32_16x16x32_bf16(d[ks & 1][i], w[ks], acc[i], 0, 0, 0);
        __builtin_amdgcn_sched_barrier(0);
    }
}
template <int KS, int NCT>
__device__ __forceinline__ void seqmix_load_d(bf16x8 (&d)[KS][NCT], const LAS bf16_t* R, int RS, int ct0, int lane) {
    const int g = lane >> 4, li = lane & 15;
    const LAS bf16_t* rbase = R + (4 * g + (li >> 2)) * RS + 16 * ct0 + 4 * (li & 3);
#pragma unroll
    for (int ks = 0; ks < KS; ++ks) seqmix_load_dstep<NCT>(d[ks], rbase + 32 * ks * RS, RS);
}
template <int KS, int NCT>
__device__ __forceinline__ void seqmix_mma_reg(f32x4 (&acc)[NCT], const bf16x8 (&d)[KS][NCT], const bf16x8 (&w)[KS]) {
#pragma unroll
    for (int ks = 0; ks < KS; ++ks)
#pragma unroll
        for (int i = 0; i < NCT; ++i) acc[i] = __builtin_amdgcn_mfma_f32_16x16x32_bf16(d[ks][i], w[ks], acc[i], 0, 0, 0);
}

__global__ void __launch_bounds__(NTHREADS, 2) mega_fwd(Args args) {
    extern __shared__ __attribute__((aligned(16))) unsigned char lds_raw[];
    LAS unsigned char* lds = (LAS unsigned char*)lds_raw;
    cg::grid_group grid = cg::this_grid();
    const int G = gridDim.x, bx = blockIdx.x;
    const int NGW = G * 8, NGT = G * NTHREADS;
    if (threadIdx.x < 4) ((LAS unsigned*)(lds + LDS_MISC))[threadIdx.x] = 0u;
    __syncthreads();
    XcdBarrier xbar; xbar.bar = (unsigned*)(gptr(args.ws) + OFF_BAR); xbar.x = xb_xcc_id(); xbar.st = (volatile LAS unsigned*)(lds + LDS_MISC);
    if (bx == 0) for (int i = threadIdx.x; i < XCD_BAR_WORDS; i += NTHREADS) xbar.bar[i] = 0u;

    if (args.ph_lo == 0) {
        int tid = threadIdx.x; asm volatile("" : "+v"(tid));
        const int lane = tid & 63, wave = __builtin_amdgcn_readfirstlane(tid >> 6);
        const int gw = bx * 8 + wave, gtid = bx * NTHREADS + tid;
        unsigned char* ws = gptr(args.ws);
        bf16_t* W1t = (bf16_t*)(ws + OFF_W1T); bf16_t* W3t = (bf16_t*)(ws + OFF_W3T); bf16_t* W2t = (bf16_t*)(ws + OFF_W2T); bf16_t* W4t = (bf16_t*)(ws + OFF_W4T);
        bf16_t* Wbv = (bf16_t*)(ws + OFF_WBV); bf16_t* Wf = (bf16_t*)(ws + OFF_WF); bf16_t* PwT = (bf16_t*)(ws + OFF_PWT); bf16_t* FwT = (bf16_t*)(ws + OFF_FWT);
        bf16_t* CS = (bf16_t*)(ws + OFF_CS); bf16_t* Wsb = (bf16_t*)(ws + OFF_WSB);
        bf16_t* T1s = (bf16_t*)(ws + OFF_T1S); bf16_t* T1p = (bf16_t*)(ws + OFF_T1P); bf16_t* T2 = (bf16_t*)(ws + OFF_T2);
            {
                LAS float* scr = (LAS float*)(lds + wave * 16384);
                const float* ewin = gptr(args.in[I_EWIN]); const float* owin = gptr(args.in[I_OWIN]);
                const float* g1v = gptr(args.in[I_NORMG]) + D;
                constexpr int NIT = 2048 + 512 + 1024 + 1536 + 512 + 1024 + 128 + 128;
                for (int it = gw; it < NIT; it += NGW) {
                    int r = it;
#define TJ(Wp, ldw_, ncols_, K_, WTp, ldt_, csp, pm_, ksp) { const int n_ = ((K_) / 64) * ((ncols_) / 32); if (r < n_) { transpose_item(Wp, ldw_, ncols_, WTp, ldt_, csp, scr, r, lane, pm_, ksp); continue; } r -= n_; }
                    TJ(ewin, 6144, 4096, 1024, W1t, 1024, nullptr, 1, nullptr)
                    TJ(ewin + 5120, 6144, 1024, 1024, W1t + (size_t)5120 * 1024, 1024, nullptr, 0, nullptr)
                    TJ(gptr(args.in[I_EWOUT]), 1024, 1024, 2048, W2t, 2048, nullptr, 0, nullptr)
                    TJ(owin, 5120, 3072, 1024, W3t, 1024, nullptr, 2, g1v)
                    TJ(owin + 4096, 5120, 1024, 1024, W3t + (size_t)5120 * 1024, 1024, nullptr, 0, g1v)
                    TJ(gptr(args.in[I_OWOUT]), 1024, 1024, 2048, W4t, 2048, nullptr, 0, nullptr)
                    { const int gq = r / 32; if (gq < 4) { transpose_item(gptr(args.in[I_EPOOLW]) + gq * 65536, 256, 256, PwT + gq * 65536, 256, gptr(args.in[I_EPOOLS]) + gq * 256, scr, r % 32, lane); continue; } r -= 128; }
                    { const int gq = r / 32; transpose_item(gptr(args.in[I_OFNET]) + gq * 65536, 256, 256, FwT + gq * 65536, 256, nullptr, scr, r % 32, lane); }
#undef TJ
                }
                constexpr int N_WBV = 131072, N_WF = 131072, N_WSB = 8192, N_CS = 16384, N_T1S = 262144, N_T1P = 16384, N_T2 = 4096;
                constexpr int NEL = N_WBV + N_WF + N_WSB + N_CS + N_T1S + N_T1P + N_T2;
                for (int it = gtid; it < NEL; it += NGT) {
                    int r = it;
                    if (r < N_WBV) { const int d = r >> 7, i8 = r & 127; cvt8(ewin + (size_t)d * 6144 + 4096 + i8 * 8, Wbv + (size_t)d * 1024 + i8 * 8); continue; } r -= N_WBV;
                    if (r < N_WF) { const int d = r >> 7, i8 = r & 127; const float gd = g1v[d]; const float* sp = owin + (size_t)d * 5120 + 3072 + i8 * 8; const f32x4 a = *(const f32x4*)sp * gd, b = *(const f32x4*)(sp + 4) * gd;
                        u32x4 o; o.x = pk2(a.x, a.y); o.y = pk2(a.z, a.w); o.z = pk2(b.x, b.y); o.w = pk2(b.z, b.w); *(u32x4*)(Wf + (size_t)d * 1024 + i8 * 8) = o; continue; } r -= N_WF;
                    if (r < N_WSB) { cvt8(gptr(args.in[I_OSGUW]) + (size_t)r * 8, Wsb + (size_t)r * 8); continue; } r -= N_WSB;
                    float o[8]; bf16_t* dst;
                    if (r < N_CS) { const int n = r >> 5, l0 = (r & 31) * 8;
#pragma unroll
                        for (int e = 0; e < 8; ++e) { const int idx = ((n & 255) * (l0 + e)) & 255; float sn, cs; sincospif((float)idx * (1.f / 128.f), &sn, &cs); o[e] = (n < 256) ? cs : sn; }
                        dst = CS + (size_t)r * 8;
                    } else if ((r -= N_CS) < N_T1S) { const int s2 = r >> 11, q = (r >> 4) & 127, p0 = (r & 15) * 8; const int k1 = q >> 1, ri = q & 1;
#pragma unroll
                        for (int e = 0; e < 8; ++e) { const int p = p0 + e, part = p >> 6, s1 = p & 63; const int idx = (k1 * (s1 * 128 + s2)) & 8191; float sn, cs; sincospif((float)idx * (1.f / 4096.f), &sn, &cs);
                            o[e] = (ri == 0) ? (part == 0 ? cs : -sn) : (part == 0 ? -sn : -cs); }
                        dst = T1s + (size_t)r * 8;
                    } else if ((r -= N_T1S) < N_T1P) { const int s2 = r >> 7, q = (r >> 2) & 31, p0 = (r & 3) * 8; const int k1 = q >> 1, ri = q & 1;
#pragma unroll
                        for (int e = 0; e < 8; ++e) { const int p = p0 + e, part = p >> 4, s1 = p & 15; const int idx = (k1 * (s1 * 128 + s2)) & 2047; float sn, cs; sincospif((float)idx * (1.f / 1024.f), &sn, &cs);
                            o[e] = (ri == 0) ? (part == 0 ? cs : -sn) : (part == 0 ? -sn : -cs); }
                        dst = T1p + (size_t)r * 8;
                    } else { r -= N_T1P; const int k2 = r >> 5, p0 = (r & 31) * 8;
#pragma unroll
                        for (int e = 0; e < 8; ++e) { const int p = p0 + e, s2 = p >> 1, ri = p & 1; const int idx = (s2 * k2) & 127; float sn, cs; sincospif((float)idx * (1.f / 64.f), &sn, &cs); o[e] = ri ? sn : cs; }
                        dst = T2 + (size_t)r * 8;
                    }
                    st8(dst, o);
                }
            }
    }
#ifndef PROBE_K
#define PROBE_K (-1)
#endif
    for (int ph = args.ph_lo; ph < args.ph_hi; ++ph)
    for (int rep = 0; rep < ((PROBE_K >= 0 && ph == PROBE_K) ? 2 : 1); ++rep) {
        int tid = threadIdx.x; asm volatile("" : "+v"(tid));
        const int lane = tid & 63, wave = __builtin_amdgcn_readfirstlane(tid >> 6);
        const int gw = bx * 8 + wave, gtid = bx * NTHREADS + tid;
        __attribute__((address_space(1))) unsigned char* wsg = (__attribute__((address_space(1))) unsigned char*)args.ws; asm volatile("" : "+s"(wsg)); unsigned char* ws = (unsigned char*)wsg;
        bf16_t* W1t = (bf16_t*)(ws + OFF_W1T); bf16_t* W3t = (bf16_t*)(ws + OFF_W3T); bf16_t* W2t = (bf16_t*)(ws + OFF_W2T); bf16_t* W4t = (bf16_t*)(ws + OFF_W4T);
        bf16_t* Wbv = (bf16_t*)(ws + OFF_WBV); bf16_t* Wf = (bf16_t*)(ws + OFF_WF); bf16_t* PwT = (bf16_t*)(ws + OFF_PWT); bf16_t* FwT = (bf16_t*)(ws + OFF_FWT);
        bf16_t* CS = (bf16_t*)(ws + OFF_CS); bf16_t* MT = (bf16_t*)(ws + OFF_MT); bf16_t* Wsb = (bf16_t*)(ws + OFF_WSB);
        bf16_t* T1s = (bf16_t*)(ws + OFF_T1S); bf16_t* T1p = (bf16_t*)(ws + OFF_T1P); bf16_t* T2 = (bf16_t*)(ws + OFF_T2);
        bf16_t* H = (bf16_t*)(ws + OFF_H); bf16_t* P = (bf16_t*)(ws + OFF_P); bf16_t* Y = (bf16_t*)(ws + OFF_Y); bf16_t* V = (bf16_t*)(ws + OFF_V);
        const float* norm_g = gptr(args.in[I_NORMG]);
        int njobs = 0; int jobk[3] = {0, 0, 0};
        int grp = 0;
        int norm0_grp = -1;
        if (ph == 0) {
            norm0_grp = 0;
        } else if (ph == 1) {
            njobs = 2; jobk[0] = 10; jobk[1] = 11;
        } else {
            int k;
            if (ph < 8) { grp = (ph - 2) >> 1; k = (ph - 2) & 1; }
            else if (ph == 8) { k = 2; }
            else if (ph < 18) { grp = (ph - 9) / 3; k = 4 + (ph - 9) % 3; }
            else { k = ph - 11; }
            bf16_t* Yg = Y + (size_t)grp * GT * YP;
            int norm1_grp = -1;
            const int S = grp == 0 ? 2048 : 8192;
            if (k == 0) { njobs = 1; jobk[0] = 1; if (grp == 0) { njobs = 3; jobk[1] = 12; jobk[2] = 13; } }
            else if (k == 1) {
                const float* convw = gptr(args.in[I_ECONV]);
                for (int wt = gw; wt < (GT / 16) * 8; wt += NGW) {
                    const int seg = ((wt & 7) + 2 * (wt / NGW)) & 7, tb = (wt >> 3) * 2 + (lane >> 5);
                    const int r0 = tb * 8, c = (seg & 3) * 256 + (lane & 31) * 8;
                    if (seg < 4) conv_item(P, Yg, convw, r0, c, S);
                    else if (seg == 4) pool_item<1>(P, Yg, r0, c, S);
                    else if (seg == 5) pool_item<2>(P, Yg, r0, c, S);
                    else if (seg == 6) pool_item<4>(P, Yg, r0, c, S);
                    else pool_item<8>(P, Yg, r0, c, S);
                }
                if (grp + 1 < NGRP) norm0_grp = grp + 1;
            }
            else if (k == 2) { njobs = 1; jobk[0] = 2; }
            else if (k == 3) { norm1_grp = 0; }
            else if (k == 4) { njobs = 1; jobk[0] = 3; }
            else if (k == 5) {
#ifndef PROBE_SUB
#define PROBE_SUB (-1)
#endif
                if (!(rep == 1 && PROBE_SUB == 1)) {
                    LAS bf16_t* R = (LAS bf16_t*)lds; constexpr int RS = 272; constexpr int NT = (GT / 128) * 4;
                    const float* gn = gptr(args.in[I_OSGUG]); const float* bs = gptr(args.in[I_OSGUB]);
                    for (int tile = bx; tile < NT; tile += G) {
                        const int chunk = tile >> 2, hd = tile & 3;
                        const int hrow = lane >> 5, l32 = lane & 31;
                        const bf16_t* src = P + (size_t)(chunk * 128 + wave * 16 + hrow) * NP1 + hd * 256 + 8 * l32;
                        u32x4 raw[8], ru[8];
#pragma unroll
                        for (int j = 0; j < 8; ++j) { raw[j] = *(const u32x4*)(src + (size_t)(2 * j) * NP1 + 1024); ru[j] = *(const u32x4*)(src + (size_t)(2 * j) * NP1); }
                        bf16x8 wfr[4];
                        seqmix_load_w<4>(wfr, Wsb + (size_t)hd * 16384 + (size_t)(16 * wave + (lane & 15)) * 128 + 4 * (lane >> 4));
                        const f32x4 g0 = *(const f32x4*)(gn + hd * 256 + 8 * l32), g1 = *(const f32x4*)(gn + hd * 256 + 8 * l32 + 4);
                        float s1[8], s2[8];
#pragma unroll
                        for (int j = 0; j < 8; ++j) { float v[8]; cvt8u(raw[j], v); s1[j] = 0.f; s2[j] = 0.f;
#pragma unroll
                            for (int e = 0; e < 8; ++e) { s1[j] += v[e]; s2[j] += v[e] * v[e]; } }
#pragma unroll
                        for (int o = 1; o < 32; o <<= 1) {
#pragma unroll
                            for (int j = 0; j < 8; ++j) { s1[j] += __shfl_xor(s1[j], o); s2[j] += __shfl_xor(s2[j], o); } }
                        LAS bf16_t* UZ = (LAS bf16_t*)(lds + 69632);
#pragma unroll
                        for (int j = 0; j < 8; ++j) {
                            const int prow_ln = wave * 16 + 2 * j + hrow;
                            const float mu = s1[j] * (1.f / 256.f), var = fmaxf(s2[j] * (1.f / 256.f) - mu * mu, 0.f);
                            const float rs = rsqrtf(var + EPS);
                            float v[8]; cvt8u(raw[j], v);
                            u32x4 o4;
                            o4.x = pk2((v[0] - mu) * rs * g0.x, (v[1] - mu) * rs * g0.y); o4.y = pk2((v[2] - mu) * rs * g0.z, (v[3] - mu) * rs * g0.w);
                            o4.z = pk2((v[4] - mu) * rs * g1.x, (v[5] - mu) * rs * g1.y); o4.w = pk2((v[6] - mu) * rs * g1.z, (v[7] - mu) * rs * g1.w);
                            *(LAS u32x4*)(R + prow_ln * RS + 8 * l32) = o4;
                            *(LAS u32x4*)(UZ + prow_ln * RS + 8 * l32) = ru[j];
                        }
                        __syncthreads();
                        const int q = 16 * wave + (lane & 15);
                        const LAS bf16_t* uzrow = UZ + q * RS + 4 * (lane >> 4);
                        const float bias = bs[hd * 128 + q];
                        f32x4 acc[16];
#pragma unroll
                        for (int i = 0; i < 16; ++i) acc[i] = (f32x4){0.f, 0.f, 0.f, 0.f};
                        seqmix_mma_tr<4, 16>(acc, R, RS, 0, wfr, lane);
                        bf16_t* yrow = Yg + (size_t)(chunk * 128 + q) * YP + hd * 256 + 4 * (lane >> 4);
#pragma unroll
                        for (int i = 0; i < 16; ++i) {
                            const u32x2 uz = *(const LAS u32x2*)(uzrow + 16 * i);
                            u32x2 o;
                            o.x = pk2(bflo(uz.x) * (acc[i][0] + bias), bfhi(uz.x) * (acc[i][1] + bias));
                            o.y = pk2(bflo(uz.y) * (acc[i][2] + bias), bfhi(uz.y) * (acc[i][3] + bias));
                            *(u32x2*)(yrow + 16 * i) = o;
                        }
                        __syncthreads();
                    }
                }
                if (!(rep == 1 && PROBE_SUB == 0)) {
                    constexpr int RSW = 72;
                    LAS bf16_t* R = (LAS bf16_t*)(lds + wave * 18432);
                    const int g4 = lane >> 4, li = lane & 15;
                    if (grp != 0) {
#define DFT1S_LOAD(W_) do { const int cs_ = (W_) & 15, s2_ = ((W_) >> 4) & 127, bl_ = (W_) >> 11; \
    _Pragma("unroll") for (int i = 0; i < 32; ++i) { const int row = 4 * i + g4, part = row >> 6, s1 = row & 63; \
        raw[i] = *(const u32x2*)(P + (size_t)(bl_ * 8192 + s1 * 128 + s2_) * NP1 + 2048 + part * 1024 + cs_ * 64 + 4 * li); } } while (0)
                        constexpr int NWT = 2 * 128 * 16;
                        u32x2 raw[32];
                        { const int w0 = gw < NWT ? gw : 0; DFT1S_LOAD(w0); }
                        for (int wt = gw; wt < NWT; wt += NGW) {
                            const int cs = wt & 15, s2 = (wt >> 4) & 127, bl = wt >> 11;
#pragma unroll
                            for (int i = 0; i < 32; ++i) *(LAS u32x2*)(R + (4 * i + g4) * RSW + 4 * li) = raw[i];
                            asm volatile("" ::: "memory");
                            { const int wn_ = wt + NGW < NWT ? wt + NGW : wt; DFT1S_LOAD(wn_); }
                            bf16x8 wc[4], wn[4];
                            const bf16_t* wbase = T1s + (size_t)s2 * 16384 + (size_t)li * 128 + 4 * g4;
                            seqmix_load_w<4>(wc, wbase);
                            bf16x8 dfr[4][4];
                            seqmix_load_d<4, 4>(dfr, R, RSW, 0, lane);
#pragma unroll
                            for (int qt = 0; qt < 8; ++qt) {
                                if (qt < 7) seqmix_load_w<4>(wn, wbase + (size_t)(16 * (qt + 1)) * 128);
                                f32x4 acc[4];
#pragma unroll
                                for (int i = 0; i < 4; ++i) acc[i] = (f32x4){0.f, 0.f, 0.f, 0.f};
                                const int q = 16 * qt + li, k1 = q >> 1, ri = q & 1;
                                seqmix_mma_reg<4, 4>(acc, dfr, wc);
                                bf16_t* vrow = V + ((size_t)((bl * 64 + k1) * VBLK + s2 * 2 + ri)) * 1024 + cs * 64 + 4 * g4;
#pragma unroll
                                for (int i = 0; i < 4; ++i) { u32x2 o; o.x = pk2(acc[i][0], acc[i][1]); o.y = pk2(acc[i][2], acc[i][3]); *(u32x2*)(vrow + 16 * i) = o; }
#pragma unroll
                                for (int ks = 0; ks < 4; ++ks) wc[ks] = wn[ks];
                            }
                            asm volatile("" ::: "memory");
                        }
#undef DFT1S_LOAD
                    } else {
                        for (int wt = gw; wt < 8 * 32 * 16; wt += NGW) {
                            const int cs = wt & 15, sq = (wt >> 4) & 31, bl = wt >> 9;
                            u32x2 raw[32];
#pragma unroll
                            for (int i = 0; i < 32; ++i) { const int row = 4 * i + g4, j = row >> 5, part = (row >> 4) & 1, s1 = row & 15;
                                raw[i] = *(const u32x2*)(P + (size_t)(bl * 2048 + s1 * 128 + 4 * sq + j) * NP1 + 2048 + part * 1024 + cs * 64 + 4 * li); }
#pragma unroll
                            for (int i = 0; i < 32; ++i) *(LAS u32x2*)(R + (4 * i + g4) * RSW + 4 * li) = raw[i];
                            asm volatile("" ::: "memory");
                            bf16x8 dfp[4][1][4];
#pragma unroll
                            for (int j = 0; j < 4; ++j) seqmix_load_d<1, 4>(dfp[j], R + 32 * j * RSW, RSW, 0, lane);
                            bf16x8 wp[8][1];
#pragma unroll
                            for (int jq = 0; jq < 8; ++jq) seqmix_load_w<1>(wp[jq], T1p + (size_t)(4 * sq + (jq >> 1)) * 1024 + (size_t)(16 * (jq & 1) + li) * 32 + 4 * g4);
#pragma unroll
                            for (int jq = 0; jq < 8; ++jq) {
                                const int j = jq >> 1, qt = jq & 1, s2 = 4 * sq + j;
                                f32x4 acc[4];
#pragma unroll
                                for (int i = 0; i < 4; ++i) acc[i] = (f32x4){0.f, 0.f, 0.f, 0.f};
                                const int q = 16 * qt + li, k1 = q >> 1, ri = q & 1;
                                seqmix_mma_reg<1, 4>(acc, dfp[j], wp[jq]);
                                bf16_t* vrow = V + ((size_t)((bl * 16 + k1) * VBLK + s2 * 2 + ri)) * 1024 + cs * 64 + 4 * g4;
#pragma unroll
                                for (int i = 0; i < 4; ++i) { u32x2 o; o.x = pk2(acc[i][0], acc[i][1]); o.y = pk2(acc[i][2], acc[i][3]); *(u32x2*)(vrow + 16 * i) = o; }
                            }
                            asm volatile("" ::: "memory");
                        }
                    }
                    __syncthreads();
                }
            }
            else if (k == 6) {
                LAS bf16_t* R = (LAS bf16_t*)lds; constexpr int RS = 144;
                const int N1 = grp == 0 ? 16 : 64, nseq = grp == 0 ? 8 : 2;
                const int NT = nseq * N1 * 8;
                const float scale = grp == 0 ? 0.001381067932f : 0.0006905339660f;
#define DFT2_LOAD(T_) do { const bf16_t* vb_ = V + (size_t)(((T_) >> 3) * VBLK) * 1024 + ((T_) & 7) * 128 + 4 * (lane & 31); \
    _Pragma("unroll") for (int i = 0; i < 16; ++i) raw[i] = *(const u32x2*)(vb_ + (size_t)(2 * (wave + 8 * i) + (lane >> 5)) * 1024); } while (0)
                for (int tile = bx; tile < NT; tile += G) {
                    const int cs = tile & 7, k1 = (tile >> 3) % N1, bl = (tile >> 3) / N1;
                    u32x2 raw[16];
                    DFT2_LOAD(tile);
                    bf16x8 wfr[8];
                    seqmix_load_w<8>(wfr, T2 + (size_t)(16 * wave + (lane & 15)) * 256 + 4 * (lane >> 4));
#pragma unroll
                    for (int i = 0; i < 16; ++i) *(LAS u32x2*)(R + (2 * (wave + 8 * i) + (lane >> 5)) * RS + 4 * (lane & 31)) = raw[i];
                    __syncthreads();
                    const int k2 = 16 * wave + (lane & 15);
                    const size_t tok = (size_t)bl * S + k1 + (size_t)N1 * k2;
                    const bf16_t* zrow = P + tok * NP1 + 4096 + cs * 128 + 4 * (lane >> 4);
                    u32x2 zr[8];
#pragma unroll
                    for (int i = 0; i < 8; ++i) zr[i] = *(const u32x2*)(zrow + 16 * i);
                    f32x4 acc[8];
#pragma unroll
                    for (int i = 0; i < 8; ++i) acc[i] = (f32x4){0.f, 0.f, 0.f, 0.f};
                    seqmix_mma_tr<8, 8>(acc, R, RS, 0, wfr, lane);
                    bf16_t* yrow = Yg + tok * YP + 1024 + cs * 128 + 4 * (lane >> 4);
#pragma unroll
                    for (int i = 0; i < 8; ++i) {
                        u32x2 o;
                        o.x = pk2(acc[i][0] * scale * bflo(zr[i].x), acc[i][1] * scale * bfhi(zr[i].x));
                        o.y = pk2(acc[i][2] * scale * bflo(zr[i].y), acc[i][3] * scale * bfhi(zr[i].y));
                        *(u32x2*)(yrow + 16 * i) = o;
                    }
                    __syncthreads();
                }
#undef DFT2_LOAD
            }
            else if (k == 7) { njobs = 1; jobk[0] = 4; }
            else {
                float* xo = gptr(args.out); const bf16_t* x2 = P;
                for (int m = 4 * gw; m < NTOK; m += 4 * NGW) rms_rowsN_bf16_to_f32<4>(x2 + (size_t)m * D, gptr(args.in[I_FINALG]), xo + (size_t)m * D, lane);
            }
            if (norm1_grp >= 0) {
                const bf16_t* x1 = (const bf16_t*)gptr(args.out) + (size_t)norm1_grp * GT * D;
                for (int m = 2 * gw; m < GT; m += 2 * NGW) rms_rows2_bf16_in(x1 + (size_t)m * D, x1 + (size_t)(m + 1) * D, norm_g + D, H + (size_t)m * D, H + (size_t)(m + 1) * D, lane);
            }
        }
        if (norm0_grp >= 0) {
            const float* xg = norm0_grp == 0 ? gptr(args.in[I_XP]) : gptr(args.in[I_XS]) + (size_t)(norm0_grp - 1) * GT * D;
            for (int m = 4 * gw; m < GT; m += 4 * NGW) rms_rowsN_bf16<4>(xg + (size_t)m * D, norm_g, H + (size_t)m * D, lane);
        }
        for (int j = 0; j < njobs; ++j) {
            const int kind = jobk[j];
            pg8::Gemm g; g.res = nullptr; g.res2 = nullptr; g.split_pm = 0; g.out = nullptr; g.resb = nullptr; g.outb = nullptr; g.stats_w = nullptr; g.stats_r = nullptr; g.O = nullptr; g.sA = 0; g.sB = 0; g.sO = 0; g.nB = 1; g.emode = 0;
            bool resmode = false;
            if (kind == 1) { g.A = H; g.Bt = W1t; g.lda = 1024; g.ldb = 1024; g.K = 1024; g.nM = GT / 256; g.nN = NP / 256; g.O = P; g.ldc = NP0; g.emode = 1; }
            else if (kind == 3) { g.A = (const bf16_t*)gptr(args.out) + (size_t)grp * GT * D; g.Bt = W3t; g.lda = 1024; g.ldb = 1024; g.K = 1024; g.nM = GT / 256; g.nN = NP / 256; g.O = P; g.ldc = NP1; g.emode = 2;
                g.stats_r = (const float*)(ws + OFF_STAT) + (size_t)grp * GT * 16; }
            else if (kind == 2) { g.A = Y; g.Bt = W2t; g.lda = YP; g.ldb = 2048; g.K = 2048; g.nM = NTOK / 256; g.nN = 4; g.ldc = 1024; resmode = true;
                g.res = gptr(args.in[I_XP]); g.res2 = gptr(args.in[I_XS]) - (size_t)GT * D; g.split_pm = GT / 256; g.outb = (bf16_t*)gptr(args.out); g.stats_w = (float*)(ws + OFF_STAT); }
            else if (kind == 4) { g.A = Y; g.Bt = W4t; g.lda = YP; g.ldb = 2048; g.K = 2048; g.nM = NTOK / 256; g.nN = 4; g.ldc = 1024; resmode = true;
                g.resb = (const bf16_t*)gptr(args.out); g.outb = P; }
            else if (kind == 10) { g.A = FwT; g.Bt = CS; g.lda = 256; g.ldb = 256; g.K = 256; g.sA = 65536; g.sB = 0; g.nM = 1; g.nN = 2; g.nB = 4; g.O = MT; g.ldc = 512; g.sO = 131072; }
            else if (kind == 11) { g.A = PwT; g.Bt = Wbv; g.lda = 256; g.ldb = 1024; g.K = 256; g.sA = 65536; g.sB = 256; g.nM = 1; g.nN = 4; g.nB = 4; g.O = W1t + (size_t)4096 * 1024; g.ldc = 1024; g.sO = 262144; }
            else { const int part = kind - 12; g.A = MT + part * 256; g.Bt = Wf; g.lda = 512; g.ldb = 1024; g.K = 256; g.sA = 131072; g.sB = 256; g.nM = 1; g.nN = 4; g.nB = 4;
                g.O = W3t + (size_t)(3072 + part * 1024) * 1024; g.ldc = 1024; g.sO = 262144; }
            pg8::Sched S; S.nM = g.nM; S.nN = g.nN; S.nwg = g.nM * g.nN; S.nB = g.nB; S.G = G; S.c = bx;
            if (resmode) pg8::gemm_phase<pg8::EpiRes>(lds, g, S, pg8::EpiRes{}, tid);
            else pg8::gemm_phase<pg8::EpiBf16>(lds, g, S, pg8::EpiBf16{}, tid);
            __syncthreads();
        }
        if (ph + 1 < args.ph_hi || (PROBE_K >= 0 && rep == 0 && ph == PROBE_K)) {
            if (ph == 0) { grid.sync();
                if (threadIdx.x == 0) (void)xb_add(&xbar.bar[XB_XCNT(xbar.x)], 1u); }
            else xcd_barrier(xbar); }
    }
#ifdef PROBE_SYNCS
    for (int i = 0; i < PROBE_SYNCS; ++i) grid.sync();
#endif
}

extern "C" void kernel_launch(void* const* d_in, const int* in_sizes, int n_in, void* d_out, int out_size, void* d_ws, size_t ws_size, hipStream_t stream) {
    static int grid = 0;
    if (grid == 0) {
        int dev = 0, cus = 0, per_cu = 0;
        if (hipGetDevice(&dev) != hipSuccess || hipDeviceGetAttribute(&cus, hipDeviceAttributeMultiprocessorCount, dev) != hipSuccess) { fprintf(stderr, "kernel_launch: device query failed\n"); grid = -1; return; }
        if (hipFuncSetAttribute((const void*)mega_fwd, hipFuncAttributeMaxDynamicSharedMemorySize, LDS_BYTES) != hipSuccess) { fprintf(stderr, "kernel_launch: hipFuncSetAttribute failed\n"); grid = -1; return; }
        if (hipOccupancyMaxActiveBlocksPerMultiprocessor(&per_cu, (const void*)mega_fwd, NTHREADS, LDS_BYTES) != hipSuccess || per_cu < 1) { fprintf(stderr, "kernel_launch: occupancy query failed (%d)\n", per_cu); grid = -1; return; }
        if (per_cu > 1) per_cu = 1;
        grid = cus * per_cu;
        if (ws_size < OFF_V + (size_t)128 * VBLK * 2048) { fprintf(stderr, "kernel_launch: workspace too small (%zu)\n", ws_size); grid = -1; return; }
    }
    if (grid < 0) return;
    Args a{};
    for (int i = 0; i < 15; ++i) a.in[i] = (const float*)d_in[i];
    a.out = (float*)d_out; a.ws = (unsigned char*)d_ws; a.ph_lo = 0; a.ph_hi = NPHASES;
    void* kargs[] = {&a};
    hipError_t e = hipLaunchCooperativeKernel((const void*)mega_fwd, dim3(grid), dim3(NTHREADS), kargs, LDS_BYTES, stream);
    if (e != hipSuccess) fprintf(stderr, "cooperative launch failed: %s (grid %d)\n", hipGetErrorString(e), grid);
}
```

```cpp
#include <hip/hip_runtime.h>
#include <hip/hip_cooperative_groups.h>
#include <cstdio>
#include <cstdint>
namespace cg = cooperative_groups;

#define LAS __attribute__((address_space(3)))
typedef unsigned short bf16_t;
typedef short bf16x8 __attribute__((ext_vector_type(8)));
typedef float f32x4 __attribute__((ext_vector_type(4)));
typedef unsigned u32x4 __attribute__((ext_vector_type(4)));
typedef unsigned u32x2 __attribute__((ext_vector_type(2)));

constexpr int D = 1024, NTOK = 49152, GT = 16384, NGRP = 3;
constexpr int NP = 6144;
constexpr int NP0 = 4096 + 64;
constexpr int NP1 = 5120 + 64;
constexpr int YP = 2048 + 64;
constexpr int VBLK = 257;
constexpr float EPS = 1e-6f;
constexpr int LDS_MISC = 147456;
constexpr int LDS_BYTES = 147456 + 256;
constexpr int NTHREADS = 512;

constexpr size_t OFF_W1T = 0;
constexpr size_t OFF_W3T = OFF_W1T + 12582912;
constexpr size_t OFF_W2T = OFF_W3T + 12582912;
constexpr size_t OFF_W4T = OFF_W2T + 4194304;
constexpr size_t OFF_WBV = OFF_W4T + 4194304;
constexpr size_t OFF_WF  = OFF_WBV + 2097152;
constexpr size_t OFF_PWT = OFF_WF + 2097152;
constexpr size_t OFF_FWT = OFF_PWT + 524288;
constexpr size_t OFF_CS  = OFF_FWT + 524288;
constexpr size_t OFF_MT  = OFF_CS + 262144;
constexpr size_t OFF_WSB = OFF_MT + 1048576;
constexpr size_t OFF_T1S = OFF_WSB + 131072;
constexpr size_t OFF_T1P = OFF_T1S + 4194304;
constexpr size_t OFF_T2  = OFF_T1P + 262144;
constexpr size_t OFF_BAR = OFF_T2 + 65536;
constexpr size_t OFF_STAT = OFF_BAR + 16384;
constexpr size_t OFF_H   = 50331648;
constexpr size_t OFF_P   = OFF_H + 33554432;
constexpr size_t OFF_Y   = OFF_P + (size_t)GT * NP1 * 2;
constexpr size_t OFF_V   = OFF_Y + (size_t)NTOK * YP * 2;
static_assert(OFF_STAT + (size_t)NTOK * 64 <= OFF_H, "ws map");

template <class T> __device__ __forceinline__ T* gptr(T* p) { typedef const __attribute__((address_space(0))) void* gvp; __builtin_assume(!__builtin_amdgcn_is_shared((gvp)p)); __builtin_assume(!__builtin_amdgcn_is_private((gvp)p)); return p; }
__device__ __forceinline__ unsigned f2bf(float f) { unsigned u = __builtin_bit_cast(unsigned, f); return (u + 0x7fffu + ((u >> 16) & 1u)) >> 16; }
typedef float f32x2_t __attribute__((ext_vector_type(2)));
typedef __bf16 bf16x2_t __attribute__((ext_vector_type(2)));
__device__ __forceinline__ unsigned pk2(float lo, float hi) { const f32x2_t v = {lo, hi}; const bf16x2_t b = __builtin_convertvector(v, bf16x2_t); return __builtin_bit_cast(unsigned, b); }
__device__ __forceinline__ float bflo(unsigned u) { return __builtin_bit_cast(float, u << 16); }
__device__ __forceinline__ float bfhi(unsigned u) { return __builtin_bit_cast(float, u & 0xffff0000u); }
__device__ __forceinline__ float silu(float z) { return z * __builtin_amdgcn_rcpf(1.f + __builtin_amdgcn_exp2f(-1.44269504089f * z)); }
__device__ __forceinline__ float wave_sum(float v) {
#pragma unroll
    for (int o = 1; o < 64; o <<= 1) v += __shfl_xor(v, o);
    return v;
}
#define LDS_WAIT() asm volatile("s_waitcnt lgkmcnt(0)" ::: "memory")
__device__ __forceinline__ void ld8(const bf16_t* p, float (&f)[8]) {
    const u32x4 v = *(const u32x4*)p;
    f[0] = bflo(v.x); f[1] = bfhi(v.x); f[2] = bflo(v.y); f[3] = bfhi(v.y); f[4] = bflo(v.z); f[5] = bfhi(v.z); f[6] = bflo(v.w); f[7] = bfhi(v.w);
}
__device__ __forceinline__ void st8(bf16_t* p, const float (&f)[8]) {
    u32x4 o; o.x = pk2(f[0], f[1]); o.y = pk2(f[2], f[3]); o.z = pk2(f[4], f[5]); o.w = pk2(f[6], f[7]);
    *(u32x4*)p = o;
}

namespace pg8 {
constexpr int BM = 256, BK = 64, HALF = 128, HTB = HALF * BK * 2, NXCD = 8, WGM = 8;
__device__ __forceinline__ int lds_byte(int r, int c) { const int st = (r >> 4) * 2 + (c >> 5), rr = r & 15, cc = c & 31, ob = rr * 64 + cc * 2; return st * 1024 + (ob ^ (((ob >> 9) & 1) << 5)); }
__device__ __forceinline__ void stage_rc(int b, int& R, int& C) { const int st = b / 1024, sb = b % 1024, swz = sb ^ (((sb >> 9) & 1) << 5); R = (st >> 1) * 16 + swz / 64; C = (st & 1) * 32 + (swz % 64) / 2; }
__device__ __forceinline__ int perm32(int rho) { const int n = rho >> 4, i = rho & 15; return 8 * (i >> 2) + 4 * n + (i & 3); }

struct Unit { int pm, pn, g; };
struct Gemm {
    const bf16_t* A; const bf16_t* Bt; int lda, ldb, K; long sA, sB;
    int nM, nN, nB;
    bf16_t* O; int ldc; long sO;
    int emode;
    const float* res; float* out;
    const bf16_t* resb; bf16_t* outb;
    float* stats_w;
    const float* stats_r;
    const float* res2; int split_pm;
};
struct Sched {
    int nM, nN, nwg, nB, G, c;
    __device__ __forceinline__ bool next(int i, Unit& u) const {
        const long L = (long)i * G + c; if (L >= (long)nwg * nB) return false;
        const int g = (int)(L / nwg); int wgid = (int)(L % nwg);
        { const int q = nwg / NXCD, r = nwg % NXCD, xcd = wgid % NXCD, off = wgid / NXCD; wgid = (xcd < r ? xcd * (q + 1) : r * (q + 1) + (xcd - r) * q) + off; }
        const int nig = WGM * nN, gid = wgid / nig, fm = gid * WGM, gsz = (nM - fm) < WGM ? (nM - fm) : WGM;
        u.pm = fm + ((wgid % nig) % gsz); u.pn = (wgid % nig) / gsz; u.g = g; return true;
    }
};
struct EpiBf16 {
    __device__ __forceinline__ void operator()(const Gemm& g, const f32x4 (&acc)[2][2][4][2], const Unit& u, int wr, int wc, int fr, int fq) const {
        const int row0 = u.pm * BM + wr * 64 + fr;
        bf16_t* base = g.O + (size_t)u.g * g.sO;
        int kind = 0, cb = u.pn * BM;
        if (g.emode == 1) { const int pn = u.pn; if (pn < 8) { kind = 2; cb = 128 * pn; } else if (pn < 16) { kind = 3; cb = 1024 + 128 * (pn - 8); } else if (pn < 20) { kind = 0; cb = 2048 + 256 * (pn - 16); } else { kind = 1; cb = 3072 + 256 * (pn - 20); } }
        else if (g.emode == 2) { const int pn = u.pn; if (pn < 8) { kind = 3; cb = 128 * pn; } else if (pn < 20) { kind = 0; cb = 1024 + 256 * (pn - 8); } else { kind = 1; cb = 4096 + 256 * (pn - 20); } }
        const int col0 = cb + wc * 32 + 8 * fq;
        float rscv[2][4];
#pragma unroll
        for (int ai = 0; ai < 2; ++ai)
#pragma unroll
            for (int m = 0; m < 4; ++m) rscv[ai][m] = 1.f;
        if (g.stats_r) {
            f32x4 sq[2][4];
#pragma unroll
            for (int ai = 0; ai < 2; ++ai)
#pragma unroll
                for (int m = 0; m < 4; ++m) sq[ai][m] = *(const f32x4*)(g.stats_r + (size_t)(row0 + ai * HALF + m * 16) * 16 + 4 * fq);
#pragma unroll
            for (int ai = 0; ai < 2; ++ai)
#pragma unroll
                for (int m = 0; m < 4; ++m) { float ss = (sq[ai][m].x + sq[ai][m].y) + (sq[ai][m].z + sq[ai][m].w);
                    ss += __shfl_xor(ss, 16); ss += __shfl_xor(ss, 32);
                    rscv[ai][m] = rsqrtf(ss * (1.f / 1024.f) + 1e-6f); }
        }
        if (kind >= 2) {
#pragma unroll
            for (int ai = 0; ai < 2; ++ai)
#pragma unroll
                for (int m = 0; m < 4; ++m) { bf16_t* rowp = base + (size_t)(row0 + ai * HALF + m * 16) * g.ldc + col0;
                    const float rsc = rscv[ai][m];
                    const f32x4 l0 = acc[ai][0][m][0] * rsc, l1 = acc[ai][0][m][1] * rsc; f32x4 h0 = acc[ai][1][m][0] * rsc, h1 = acc[ai][1][m][1] * rsc;
                    if (kind == 3) { h0 = (f32x4){silu(h0[0]), silu(h0[1]), silu(h0[2]), silu(h0[3])}; h1 = (f32x4){silu(h1[0]), silu(h1[1]), silu(h1[2]), silu(h1[3])}; }
                    const f32x4 v0 = l0 * h0, v1 = l1 * h1;
                    u32x4 w; w.x = pk2(v0[0], v0[1]); w.y = pk2(v0[2], v0[3]); w.z = pk2(v1[0], v1[1]); w.w = pk2(v1[2], v1[3]);
                    *(u32x4*)rowp = w; }
        } else {
#pragma unroll
            for (int ai = 0; ai < 2; ++ai)
#pragma unroll
                for (int m = 0; m < 4; ++m) { bf16_t* rowp = base + (size_t)(row0 + ai * HALF + m * 16) * g.ldc + col0;
#pragma unroll
                    for (int bj = 0; bj < 2; ++bj) { f32x4 v0 = acc[ai][bj][m][0] * rscv[ai][m], v1 = acc[ai][bj][m][1] * rscv[ai][m];
                        if (kind == 1) { v0 = (f32x4){silu(v0[0]), silu(v0[1]), silu(v0[2]), silu(v0[3])}; v1 = (f32x4){silu(v1[0]), silu(v1[1]), silu(v1[2]), silu(v1[3])}; }
                        u32x4 w; w.x = pk2(v0[0], v0[1]); w.y = pk2(v0[2], v0[3]); w.z = pk2(v1[0], v1[1]); w.w = pk2(v1[2], v1[3]);
                        *(u32x4*)(rowp + bj * HALF) = w; } }
        }
    }
};
struct EpiRes {
    __device__ __forceinline__ void operator()(const Gemm& g, const f32x4 (&acc)[2][2][4][2], const Unit& u, int wr, int wc, int fr, int fq) const {
        const int row0 = u.pm * BM + wr * 64 + fr, col0 = u.pn * BM + wc * 32 + 8 * fq;
        const float* resp = (u.pm >= g.split_pm) ? g.res2 : g.res;
#pragma unroll
        for (int ai = 0; ai < 2; ++ai)
#pragma unroll
            for (int m = 0; m < 4; ++m) { const size_t ro = (size_t)(row0 + ai * HALF + m * 16) * g.ldc + col0;
                float ssq = 0.f;
#pragma unroll
                for (int bj = 0; bj < 2; ++bj) {
                    f32x4 r0, r1;
                    if (g.resb) { const u32x4 rv = *(const u32x4*)(g.resb + ro + bj * HALF);
                        r0 = (f32x4){bflo(rv.x), bfhi(rv.x), bflo(rv.y), bfhi(rv.y)}; r1 = (f32x4){bflo(rv.z), bfhi(rv.z), bflo(rv.w), bfhi(rv.w)}; }
                    else { r0 = *(const f32x4*)(resp + ro + bj * HALF); r1 = *(const f32x4*)(resp + ro + bj * HALF + 4); }
                    const f32x4 x0 = r0 + acc[ai][bj][m][0], x1 = r1 + acc[ai][bj][m][1];
                    ssq += ((x0[0] * x0[0] + x0[1] * x0[1]) + (x0[2] * x0[2] + x0[3] * x0[3])) + ((x1[0] * x1[0] + x1[1] * x1[1]) + (x1[2] * x1[2] + x1[3] * x1[3]));
                    u32x4 w; w.x = pk2(x0[0], x0[1]); w.y = pk2(x0[2], x0[3]); w.z = pk2(x1[0], x1[1]); w.w = pk2(x1[2], x1[3]);
                    *(u32x4*)(g.outb + ro + bj * HALF) = w; }
                if (g.stats_w) { ssq += __shfl_xor(ssq, 16); ssq += __shfl_xor(ssq, 32);
                    if (fq == 0) g.stats_w[(size_t)(row0 + ai * HALF + m * 16) * 16 + u.pn * 4 + wc] = ssq; } }
    }
};

template <class Epi>
__device__ __forceinline__ void gemm_phase(LAS unsigned char* lds, const Gemm& g, const Sched& S, const Epi& E, const int tid) {
    const int wid = __builtin_amdgcn_readfirstlane(tid >> 6), lane = tid & 63, wr = wid >> 2, wc = wid & 3, fr = lane & 15, fq = lane >> 4;
    const int K = g.K, nt = K / BK;
    unsigned voffA[2], voffB[2];
#pragma unroll
    for (int i = 0; i < 2; ++i) { int R, C; stage_rc(tid * 16 + i * 8192, R, C); const int Rb = (R & ~31) + perm32(R & 31);
        voffA[i] = (unsigned)(R * g.lda + C) * 2u; voffB[i] = (unsigned)(Rb * g.ldb + C) * 2u; }
    const size_t kstep = (size_t)(BK * 2);
    const size_t hstepA = (size_t)HALF * g.lda * 2, hstepB = (size_t)HALF * g.ldb * 2;
    const unsigned ldsw = (unsigned)wid * 1024u;
    const int aoff = lds_byte(wr * 64 + fr, fq * 8), boff = lds_byte(wc * 32 + fr, fq * 8);
#define PG8_SA(b, h) (((b) * 2 + (h)) * HTB)
#define PG8_SB(b, h) ((4 + (b) * 2 + (h)) * HTB)
#define PG8_STAGE(bufoff, gbase, voff) do { _Pragma("unroll") for (int _i = 0; _i < 2; ++_i) \
        __builtin_amdgcn_global_load_lds((const unsigned*)((const char*)(gbase) + (voff)[_i]), (LAS unsigned*)(lds + (bufoff) + ldsw + _i * 8192), 16, 0, 0); } while (0)
#define PG8_LDA(dst, b, h) do { _Pragma("unroll") for (int m = 0; m < 4; ++m) _Pragma("unroll") for (int k = 0; k < 2; ++k) dst[m][k] = *(const LAS bf16x8*)(lds + PG8_SA(b, h) + aoff + m * 2048 + k * 1024); } while (0)
#define PG8_LDB(dst, b, h) do { _Pragma("unroll") for (int n = 0; n < 2; ++n) _Pragma("unroll") for (int k = 0; k < 2; ++k) dst[n][k] = *(const LAS bf16x8*)(lds + PG8_SB(b, h) + boff + n * 2048 + k * 1024); } while (0)
#define PG8_MMA(ai, bj, At, Bt) do { __builtin_amdgcn_s_setprio(1); _Pragma("unroll") for (int m = 0; m < 4; ++m) _Pragma("unroll") for (int n = 0; n < 2; ++n) _Pragma("unroll") for (int k = 0; k < 2; ++k) \
        acc[ai][bj][m][n] = __builtin_amdgcn_mfma_f32_16x16x32_bf16(Bt[n][k], At[m][k], acc[ai][bj][m][n], 0, 0, 0); __builtin_amdgcn_s_setprio(0); } while (0)
#define PG8_WAIT_V(n) asm volatile("s_waitcnt vmcnt(" #n ")" ::: "memory")
#define PG8_WAIT_L(n) asm volatile("s_waitcnt lgkmcnt(" #n ")" ::: "memory")
#define PG8_BAR __builtin_amdgcn_s_barrier()
#define PG8_SCHED __builtin_amdgcn_sched_barrier(0)
#define PG8_APTR(u) ((const char*)(g.A + (size_t)(u).g * g.sA) + (size_t)(u).pm * 2 * hstepA)
#define PG8_BPTR(u) ((const char*)(g.Bt + (size_t)(u).g * g.sB) + (size_t)(u).pn * 2 * hstepB)
    Unit cur, nxt; int ui = 0;
    if (!S.next(0, cur)) return;
    f32x4 acc[2][2][4][2];
    float zf = 0.f; asm volatile("" : "+v"(zf));
#pragma unroll
    for (int a = 0; a < 2; ++a)
#pragma unroll
        for (int b = 0; b < 2; ++b)
#pragma unroll
            for (int m = 0; m < 4; ++m)
#pragma unroll
                for (int n = 0; n < 2; ++n) acc[a][b][m][n] = (f32x4){zf, zf, zf, zf};
    bf16x8 At[4][2], B0[2][2], B1[2][2];
    const char* cA = PG8_APTR(cur); const char* cB = PG8_BPTR(cur);
    PG8_STAGE(PG8_SB(0, 0), cB, voffB); PG8_STAGE(PG8_SB(0, 1), cB + hstepB, voffB); PG8_STAGE(PG8_SA(0, 0), cA, voffA); PG8_STAGE(PG8_SA(0, 1), cA + hstepA, voffA);
    if (wr == 1) PG8_BAR;
    PG8_WAIT_V(2); PG8_BAR;
    PG8_STAGE(PG8_SB(1, 0), cB + kstep, voffB); PG8_STAGE(PG8_SA(1, 0), cA + kstep, voffA); PG8_STAGE(PG8_SB(1, 1), cB + hstepB + kstep, voffB);
    PG8_WAIT_V(6); PG8_BAR;
    for (;;) {
        const bool has_next = S.next(ui + 1, nxt);
        const char* nA = has_next ? PG8_APTR(nxt) : cA; const char* nB = has_next ? PG8_BPTR(nxt) : cB;
        for (int t = 0; t < nt; t += 2) {
            const bool last = (t == nt - 2);
            const char* a1 = cA + (size_t)(t + 1) * kstep;
            const char* a2 = last ? nA : cA + (size_t)(t + 2) * kstep; const char* b2 = last ? nB : cB + (size_t)(t + 2) * kstep;
            const char* a3 = a2 + kstep; const char* b3 = b2 + kstep;
            PG8_LDB(B0, 0, 0); PG8_LDB(B1, 0, 1); PG8_SCHED; PG8_LDA(At, 0, 0); PG8_STAGE(PG8_SA(1, 1), a1 + hstepA, voffA);
            PG8_WAIT_V(8); PG8_WAIT_L(0); PG8_BAR; PG8_MMA(0, 0, At, B0); PG8_MMA(0, 1, At, B1); PG8_BAR; PG8_SCHED;
            PG8_LDA(At, 0, 1); PG8_STAGE(PG8_SB(0, 0), b2, voffB); PG8_STAGE(PG8_SB(0, 1), b2 + hstepB, voffB); PG8_STAGE(PG8_SA(0, 0), a2, voffA);
            PG8_WAIT_V(8); PG8_WAIT_L(0); PG8_BAR; PG8_MMA(1, 0, At, B0); PG8_MMA(1, 1, At, B1); PG8_BAR; PG8_SCHED;
            PG8_LDB(B0, 1, 0); PG8_LDB(B1, 1, 1); PG8_SCHED; PG8_LDA(At, 1, 0); PG8_STAGE(PG8_SA(0, 1), a2 + hstepA, voffA);
            PG8_WAIT_V(8); PG8_WAIT_L(0); PG8_BAR; PG8_MMA(0, 0, At, B0); PG8_MMA(0, 1, At, B1); PG8_BAR; PG8_SCHED;
            PG8_LDA(At, 1, 1); PG8_STAGE(PG8_SB(1, 0), b3, voffB); PG8_STAGE(PG8_SB(1, 1), b3 + hstepB, voffB); PG8_STAGE(PG8_SA(1, 0), a3, voffA);
            PG8_WAIT_V(8); PG8_WAIT_L(0); PG8_BAR; PG8_MMA(1, 0, At, B0); PG8_MMA(1, 1, At, B1); PG8_BAR; PG8_SCHED;
        }
        if (wr == 0) PG8_BAR;
        E(g, acc, cur, wr, wc, fr, fq);
        if (!has_next) break;
#pragma unroll
        for (int a = 0; a < 2; ++a)
#pragma unroll
            for (int b = 0; b < 2; ++b)
#pragma unroll
                for (int m = 0; m < 4; ++m)
#pragma unroll
                    for (int n = 0; n < 2; ++n) acc[a][b][m][n] = (f32x4){zf, zf, zf, zf};
        cur = nxt; cA = nA; cB = nB; ++ui;
        if (wr == 1) PG8_BAR;
    }
    PG8_WAIT_V(0);
    PG8_BAR;
#undef PG8_SA
#undef PG8_SB
#undef PG8_STAGE
#undef PG8_LDA
#undef PG8_LDB
#undef PG8_MMA
#undef PG8_WAIT_V
#undef PG8_WAIT_L
#undef PG8_BAR
#undef PG8_SCHED
#undef PG8_APTR
#undef PG8_BPTR
}
}

#define XB_TMO      128
#define XB_XCNT(j)  (256  + 64 * (j))
#define XB_XSUB(j)  (1280 + 64 * (j))
#define XB_XGEN(j)  (2304 + 64 * (j))
#define XB_TOP      3328
#define XB_TOPGEN   3392
#define XCD_BAR_WORDS 3456
#define XB_SPIN_CAP (1u << 18)

__device__ __forceinline__ unsigned xb_ld(unsigned* p)              { return __hip_atomic_load(p, __ATOMIC_RELAXED, __HIP_MEMORY_SCOPE_AGENT); }
__device__ __forceinline__ unsigned xb_add(unsigned* p, unsigned v) { return __hip_atomic_fetch_add(p, v, __ATOMIC_RELAXED, __HIP_MEMORY_SCOPE_AGENT); }
__device__ __forceinline__ unsigned xb_xcc_id() { return (unsigned)__builtin_amdgcn_s_getreg((3 << 11) | 20) & 0xFu; }
#define XB_SPIN(cond, bar) do { unsigned _sp = 0; while (cond) { __builtin_amdgcn_s_sleep(1); \
    if ((++_sp & 255u) == 0u) { if (xb_ld(&(bar)[XB_TMO])) break; if (_sp > XB_SPIN_CAP) { atomicAdd(&(bar)[XB_TMO], 1u); break; } } } } while (0)

struct XcdBarrier {
    unsigned* bar; unsigned x;
    volatile LAS unsigned* st;
};

__device__ __forceinline__ XcdBarrier xcd_barrier_post(unsigned* bar, volatile LAS unsigned* st) {
    XcdBarrier b; b.bar = bar; b.x = xb_xcc_id(); b.st = st;
    if (threadIdx.x == 0) (void)xb_add(&bar[XB_XCNT(b.x)], 1u);
    return b;
}
__device__ __forceinline__ void xcd_barrier_complete(unsigned* bar, unsigned x, unsigned& nloc, unsigned& nx) {
    const unsigned G = gridDim.x * gridDim.y * gridDim.z;
    unsigned sum, cnt, mine, sp = 0u;
    for (;;) {
        sum = 0u; cnt = 0u; mine = 0u;
#pragma unroll
        for (unsigned j = 0; j < 16; ++j) { const unsigned c = xb_ld(&bar[XB_XCNT(j)]); sum += c; cnt += (c > 0u) ? 1u : 0u; mine = (j == x) ? c : mine; }
        if (sum == G) break;
        __builtin_amdgcn_s_sleep(1);
        if ((++sp & 255u) == 0u) { if (xb_ld(&bar[XB_TMO])) break; if (sp > XB_SPIN_CAP) { atomicAdd(&bar[XB_TMO], 1u); break; } }
    }
    nloc = mine > 0u ? mine : 1u; nx = cnt > 0u ? cnt : 1u;
}

__device__ __forceinline__ void xcd_barrier(const XcdBarrier& b) {
    asm volatile("s_waitcnt vmcnt(0)" ::: "memory");
    __syncthreads();
    if (threadIdx.x == 0) {
        unsigned* bar = b.bar;
        __builtin_amdgcn_s_waitcnt(0);
        unsigned nloc = b.st[0], nx = b.st[1];
        if (nloc == 0u) { xcd_barrier_complete(bar, b.x, nloc, nx); b.st[0] = nloc; b.st[1] = nx; }
        const unsigned old = xb_add(&bar[XB_XSUB(b.x)], 1u);
        const unsigned gen = old / nloc;
        if (old + 1u == (gen + 1u) * nloc) {
            __builtin_amdgcn_fence(__ATOMIC_RELEASE, "agent");
            asm volatile("s_waitcnt vmcnt(0)" ::: "memory");
            const unsigned og = xb_add(&bar[XB_TOP], 1u);
            const unsigned tg = og / nx;
            if (og + 1u == (tg + 1u) * nx) xb_add(&bar[XB_TOPGEN], 1u);
            else XB_SPIN(xb_ld(&bar[XB_TOPGEN]) == tg, bar);
            __builtin_amdgcn_fence(__ATOMIC_ACQUIRE, "agent");
            xb_add(&bar[XB_XGEN(b.x)], 1u);
            asm volatile("s_waitcnt vmcnt(0)" ::: "memory");
        } else {
            XB_SPIN(xb_ld(&bar[XB_XGEN(b.x)]) == gen, bar);
            __builtin_amdgcn_fence(__ATOMIC_ACQUIRE, "agent");
            asm volatile("s_waitcnt vmcnt(0)" ::: "memory");
        }
    }
    __syncthreads();
}


struct Args { const float* in[15]; float* out; unsigned char* ws; int ph_lo, ph_hi; };
enum { I_XP = 0, I_XS, I_NORMG, I_EWIN, I_ECONV, I_EPOOLW, I_EPOOLS, I_EWOUT, I_OWIN, I_OSGUG, I_OSGUW, I_OSGUB, I_OFNET, I_OWOUT, I_FINALG };
constexpr int NPHASES = 20;

__device__ __forceinline__ void transpose_item(const float* W, int ldw, int ncols, bf16_t* WT, int ldt, const float* cscale, LAS float* scr, int item, int lane, int pmode = 0, const float* kscale = nullptr) {
    const int nblk = ncols / 32, kb = item / nblk, nb = item % nblk, k0 = 64 * kb, n0 = 32 * nb;
    int d0 = n0;
    { const int seg = n0 >> 10, ch0 = n0 & 1023, pr = 256 * (ch0 >> 7) + (ch0 & 127);
      if (pmode == 1) d0 = ((seg & 1) ? 2048 : 0) + ((seg & 2) ? 128 : 0) + pr;
      else if (pmode == 2) d0 = (seg == 1) ? 2048 + ch0 : ((seg == 2) ? 128 : 0) + pr; }
    const float sc = cscale ? cscale[n0 + (lane & 31)] : 1.f;
#pragma unroll 8
    for (int i = 0; i < 32; ++i) { const int kk = 2 * i + (lane >> 5); scr[kk * 33 + (lane & 31)] = W[(size_t)(k0 + kk) * ldw + n0 + (lane & 31)] * (kscale ? sc * kscale[k0 + kk] : sc); }
    LDS_WAIT();
    const int c = lane & 7;
#pragma unroll
    for (int j = 0; j < 4; ++j) { const int n = (lane >> 3) + 8 * j; const LAS float* s = scr + (8 * c) * 33 + n;
        u32x4 o; o.x = pk2(s[0 * 33], s[1 * 33]); o.y = pk2(s[2 * 33], s[3 * 33]); o.z = pk2(s[4 * 33], s[5 * 33]); o.w = pk2(s[6 * 33], s[7 * 33]);
        *(u32x4*)(WT + (size_t)(d0 + n) * ldt + k0 + 8 * c) = o; }
    LDS_WAIT();
}
__device__ __forceinline__ void rms_row_bf16(const float* xrow, const float* gain, bf16_t* orow, int lane) {
    const f32x4* xr = (const f32x4*)xrow + lane; const f32x4* gr = (const f32x4*)gain + lane;
    f32x4 v[4]; float s = 0.f;
#pragma unroll
    for (int j = 0; j < 4; ++j) { v[j] = xr[64 * j]; s += (v[j].x * v[j].x + v[j].y * v[j].y) + (v[j].z * v[j].z + v[j].w * v[j].w); }
    const float r = rsqrtf(wave_sum(s) * (1.f / D) + EPS);
    u32x2* o8 = (u32x2*)orow + lane;
#pragma unroll
    for (int j = 0; j < 4; ++j) { const f32x4 gg = gr[64 * j]; u32x2 o; o.x = pk2(v[j].x * r * gg.x, v[j].y * r * gg.y); o.y = pk2(v[j].z * r * gg.z, v[j].w * r * gg.w); o8[64 * j] = o; }
}
__device__ __forceinline__ void rms_row_f32_inplace(float* xrow, const float* gain, int lane) {
    f32x4* xr = (f32x4*)xrow + lane; const f32x4* gr = (const f32x4*)gain + lane;
    f32x4 v[4]; float s = 0.f;
#pragma unroll
    for (int j = 0; j < 4; ++j) { v[j] = xr[64 * j]; s += (v[j].x * v[j].x + v[j].y * v[j].y) + (v[j].z * v[j].z + v[j].w * v[j].w); }
    const float r = rsqrtf(wave_sum(s) * (1.f / D) + EPS);
#pragma unroll
    for (int j = 0; j < 4; ++j) { const f32x4 gg = gr[64 * j]; xr[64 * j] = v[j] * r * gg; }
}
__device__ __forceinline__ void cvt8(const float* src, bf16_t* dst) {
    const f32x4 a = *(const f32x4*)src, b = *(const f32x4*)(src + 4);
    u32x4 o; o.x = pk2(a.x, a.y); o.y = pk2(a.z, a.w); o.z = pk2(b.x, b.y); o.w = pk2(b.z, b.w);
    *(u32x4*)dst = o;
}


__device__ __forceinline__ void cvt8u(const u32x4 v, float (&f)[8]) {
    f[0] = bflo(v.x); f[1] = bfhi(v.x); f[2] = bflo(v.y); f[3] = bfhi(v.y); f[4] = bflo(v.z); f[5] = bfhi(v.z); f[6] = bflo(v.w); f[7] = bfhi(v.w);
}
template <int HW>
__device__ __forceinline__ void pool_item(const bf16_t* P, bf16_t* Y, int r0, int c, int S) {
    constexpr int NR = 8 + 2 * HW;
    const int s0 = r0 & (S - 1);
    const bf16_t* base = P + (size_t)r0 * NP0 + 2048 + c;
    u32x4 raw[NR], zr[8];
#pragma unroll
    for (int j = 0; j < NR; ++j) { const int t = s0 - HW + j; raw[j] = (t >= 0 && t < S) ? *(const u32x4*)(base + (ptrdiff_t)(j - HW) * NP0) : (u32x4){0u, 0u, 0u, 0u}; }
#pragma unroll
    for (int i = 0; i < 8; ++i) zr[i] = *(const u32x4*)(base + (size_t)i * NP0 + 1024);
    float sum[8];
#pragma unroll
    for (int e = 0; e < 8; ++e) sum[e] = 0.f;
#pragma unroll
    for (int j = 0; j < 2 * HW; ++j) { float v[8]; cvt8u(raw[j], v);
#pragma unroll
        for (int e = 0; e < 8; ++e) sum[e] += v[e]; }
#pragma unroll
    for (int i = 0; i < 8; ++i) {
        const int lo = max(s0 + i - HW, 0), hi = min(s0 + i + HW, S);
        const float inv = 1.f / (float)(hi - lo);
        float v[8], z[8], o[8]; cvt8u(raw[i + HW], v); cvt8u(zr[i], z);
#pragma unroll
        for (int e = 0; e < 8; ++e) o[e] = (sum[e] * inv - v[e]) * z[e];
        st8(Y + (size_t)(r0 + i) * YP + 1024 + c, o);
        if (i < 7) { float a[8], b[8]; cvt8u(raw[i + 2 * HW], a); cvt8u(raw[i], b);
#pragma unroll
            for (int e = 0; e < 8; ++e) sum[e] += a[e] - b[e]; }
    }
}
__device__ __forceinline__ void conv_item(const bf16_t* P, bf16_t* Y, const float* convw, int r0, int c, int S) {
    const int s0 = r0 & (S - 1);
    const bf16_t* base = P + (size_t)r0 * NP0 + c;
    u32x4 ur[10], gr[8];
#pragma unroll
    for (int j = 0; j < 10; ++j) { const int t = s0 - 1 + j; ur[j] = (t >= 0 && t < S) ? *(const u32x4*)(base + (ptrdiff_t)(j - 1) * NP0) : (u32x4){0u, 0u, 0u, 0u}; }
#pragma unroll
    for (int i = 0; i < 8; ++i) gr[i] = *(const u32x4*)(base + (size_t)i * NP0 + 1024);
    float w[3][8];
#pragma unroll
    for (int k = 0; k < 3; ++k) { const f32x4 w0 = *(const f32x4*)(convw + k * 1024 + c), w1 = *(const f32x4*)(convw + k * 1024 + c + 4);
        w[k][0] = w0.x; w[k][1] = w0.y; w[k][2] = w0.z; w[k][3] = w0.w; w[k][4] = w1.x; w[k][5] = w1.y; w[k][6] = w1.z; w[k][7] = w1.w; }
    float u0[8], u1[8], u2[8];
    cvt8u(ur[0], u0); cvt8u(ur[1], u1);
#pragma unroll
    for (int i = 0; i < 8; ++i) {
        float gt[8], o[8]; cvt8u(ur[i + 2], u2); cvt8u(gr[i], gt);
#pragma unroll
        for (int e = 0; e < 8; ++e) { const float y = w[0][e] * u0[e] + w[1][e] * u1[e] + w[2][e] * u2[e]; o[e] = gt[e] * y; u0[e] = u1[e]; u1[e] = u2[e]; }
        st8(Y + (size_t)(r0 + i) * YP + c, o);
    }
}
template <int NR>
__device__ __forceinline__ void rms_rowsN_bf16(const float* x, const float* gain, bf16_t* o, int lane) {
    f32x4 v[NR][4]; float s[NR];
#pragma unroll
    for (int r = 0; r < NR; ++r)
#pragma unroll
        for (int j = 0; j < 4; ++j) v[r][j] = ((const f32x4*)(x + (size_t)r * D))[lane + 64 * j];
#pragma unroll
    for (int r = 0; r < NR; ++r) { s[r] = 0.f;
#pragma unroll
        for (int j = 0; j < 4; ++j) s[r] += (v[r][j].x * v[r][j].x + v[r][j].y * v[r][j].y) + (v[r][j].z * v[r][j].z + v[r][j].w * v[r][j].w); }
#pragma unroll
    for (int of = 1; of < 64; of <<= 1)
#pragma unroll
        for (int r = 0; r < NR; ++r) s[r] += __shfl_xor(s[r], of);
#pragma unroll
    for (int j = 0; j < 4; ++j) { const f32x4 gg = ((const f32x4*)gain)[lane + 64 * j];
#pragma unroll
        for (int r = 0; r < NR; ++r) { const float rs = rsqrtf(s[r] * (1.f / D) + EPS); u32x2 a;
            a.x = pk2(v[r][j].x * rs * gg.x, v[r][j].y * rs * gg.y); a.y = pk2(v[r][j].z * rs * gg.z, v[r][j].w * rs * gg.w);
            ((u32x2*)(o + (size_t)r * D))[lane + 64 * j] = a; } }
}
template <int NR>
__device__ __forceinline__ void rms_rowsN_bf16_to_f32(const bf16_t* x, const float* gain, float* o, int lane) {
    u32x4 raw[NR][2]; float s[NR];
#pragma unroll
    for (int r = 0; r < NR; ++r)
#pragma unroll
        for (int j = 0; j < 2; ++j) raw[r][j] = *(const u32x4*)(x + (size_t)r * D + 512 * j + 8 * lane);
#pragma unroll
    for (int r = 0; r < NR; ++r) { s[r] = 0.f;
#pragma unroll
        for (int j = 0; j < 2; ++j) { float v[8]; cvt8u(raw[r][j], v);
#pragma unroll
            for (int e = 0; e < 8; ++e) s[r] += v[e] * v[e]; } }
#pragma unroll
    for (int of = 1; of < 64; of <<= 1)
#pragma unroll
        for (int r = 0; r < NR; ++r) s[r] += __shfl_xor(s[r], of);
#pragma unroll
    for (int j = 0; j < 2; ++j) { const f32x4 g0 = *(const f32x4*)(gain + 512 * j + 8 * lane), g1 = *(const f32x4*)(gain + 512 * j + 8 * lane + 4);
#pragma unroll
        for (int r = 0; r < NR; ++r) { const float rs = rsqrtf(s[r] * (1.f / D) + EPS); float v[8]; cvt8u(raw[r][j], v);
            float* op = o + (size_t)r * D + 512 * j + 8 * lane;
            *(f32x4*)op = (f32x4){v[0] * rs * g0.x, v[1] * rs * g0.y, v[2] * rs * g0.z, v[3] * rs * g0.w};
            *(f32x4*)(op + 4) = (f32x4){v[4] * rs * g1.x, v[5] * rs * g1.y, v[6] * rs * g1.z, v[7] * rs * g1.w}; } }
}
__device__ __forceinline__ void rms_rows2_bf16(const float* x0, const float* x1, const float* gain, bf16_t* o0, bf16_t* o1, int lane) {
    const f32x4* xr0 = (const f32x4*)x0 + lane; const f32x4* xr1 = (const f32x4*)x1 + lane; const f32x4* gr = (const f32x4*)gain + lane;
    f32x4 v[4], w[4]; float s = 0.f, t = 0.f;
#pragma unroll
    for (int j = 0; j < 4; ++j) { v[j] = xr0[64 * j]; w[j] = xr1[64 * j]; }
#pragma unroll
    for (int j = 0; j < 4; ++j) { s += (v[j].x * v[j].x + v[j].y * v[j].y) + (v[j].z * v[j].z + v[j].w * v[j].w); t += (w[j].x * w[j].x + w[j].y * w[j].y) + (w[j].z * w[j].z + w[j].w * w[j].w); }
#pragma unroll
    for (int o = 1; o < 64; o <<= 1) { s += __shfl_xor(s, o); t += __shfl_xor(t, o); }
    const float r = rsqrtf(s * (1.f / D) + EPS), q = rsqrtf(t * (1.f / D) + EPS);
    u32x2* p0 = (u32x2*)o0 + lane; u32x2* p1 = (u32x2*)o1 + lane;
#pragma unroll
    for (int j = 0; j < 4; ++j) { const f32x4 gg = gr[64 * j]; u32x2 a, b;
        a.x = pk2(v[j].x * r * gg.x, v[j].y * r * gg.y); a.y = pk2(v[j].z * r * gg.z, v[j].w * r * gg.w);
        b.x = pk2(w[j].x * q * gg.x, w[j].y * q * gg.y); b.y = pk2(w[j].z * q * gg.z, w[j].w * q * gg.w);
        p0[64 * j] = a; p1[64 * j] = b; }
}
__device__ __forceinline__ void rms_rows2_bf16_in(const bf16_t* x0, const bf16_t* x1, const float* gain, bf16_t* o0, bf16_t* o1, int lane) {
    float v[2][8], w[2][8]; float s = 0.f, t = 0.f;
#pragma unroll
    for (int j = 0; j < 2; ++j) { ld8(x0 + 512 * j + 8 * lane, v[j]); ld8(x1 + 512 * j + 8 * lane, w[j]); }
#pragma unroll
    for (int j = 0; j < 2; ++j)
#pragma unroll
        for (int e = 0; e < 8; ++e) { s += v[j][e] * v[j][e]; t += w[j][e] * w[j][e]; }
#pragma unroll
    for (int o = 1; o < 64; o <<= 1) { s += __shfl_xor(s, o); t += __shfl_xor(t, o); }
    const float r = rsqrtf(s * (1.f / D) + EPS), q = rsqrtf(t * (1.f / D) + EPS);
#pragma unroll
    for (int j = 0; j < 2; ++j) { const f32x4 g0 = *(const f32x4*)(gain + 512 * j + 8 * lane), g1 = *(const f32x4*)(gain + 512 * j + 8 * lane + 4);
        float a[8], b[8];
        a[0] = v[j][0] * r * g0.x; a[1] = v[j][1] * r * g0.y; a[2] = v[j][2] * r * g0.z; a[3] = v[j][3] * r * g0.w; a[4] = v[j][4] * r * g1.x; a[5] = v[j][5] * r * g1.y; a[6] = v[j][6] * r * g1.z; a[7] = v[j][7] * r * g1.w;
        b[0] = w[j][0] * q * g0.x; b[1] = w[j][1] * q * g0.y; b[2] = w[j][2] * q * g0.z; b[3] = w[j][3] * q * g0.w; b[4] = w[j][4] * q * g1.x; b[5] = w[j][5] * q * g1.y; b[6] = w[j][6] * q * g1.z; b[7] = w[j][7] * q * g1.w;
        st8(o0 + 512 * j + 8 * lane, a); st8(o1 + 512 * j + 8 * lane, b); }
}
__device__ __forceinline__ void rms_rows2_bf16_to_f32(const bf16_t* x0, const bf16_t* x1, const float* gain, float* o0, float* o1, int lane) {
    float v[2][8], w[2][8]; float s = 0.f, t = 0.f;
#pragma unroll
    for (int j = 0; j < 2; ++j) { ld8(x0 + 512 * j + 8 * lane, v[j]); ld8(x1 + 512 * j + 8 * lane, w[j]); }
#pragma unroll
    for (int j = 0; j < 2; ++j)
#pragma unroll
        for (int e = 0; e < 8; ++e) { s += v[j][e] * v[j][e]; t += w[j][e] * w[j][e]; }
#pragma unroll
    for (int o = 1; o < 64; o <<= 1) { s += __shfl_xor(s, o); t += __shfl_xor(t, o); }
    const float r = rsqrtf(s * (1.f / D) + EPS), q = rsqrtf(t * (1.f / D) + EPS);
#pragma unroll
    for (int j = 0; j < 2; ++j) { const f32x4 g0 = *(const f32x4*)(gain + 512 * j + 8 * lane), g1 = *(const f32x4*)(gain + 512 * j + 8 * lane + 4);
        *(f32x4*)(o0 + 512 * j + 8 * lane) = (f32x4){v[j][0] * r * g0.x, v[j][1] * r * g0.y, v[j][2] * r * g0.z, v[j][3] * r * g0.w};
        *(f32x4*)(o0 + 512 * j + 8 * lane + 4) = (f32x4){v[j][4] * r * g1.x, v[j][5] * r * g1.y, v[j][6] * r * g1.z, v[j][7] * r * g1.w};
        *(f32x4*)(o1 + 512 * j + 8 * lane) = (f32x4){w[j][0] * q * g0.x, w[j][1] * q * g0.y, w[j][2] * q * g0.z, w[j][3] * q * g0.w};
        *(f32x4*)(o1 + 512 * j + 8 * lane + 4) = (f32x4){w[j][4] * q * g1.x, w[j][5] * q * g1.y, w[j][6] * q * g1.z, w[j][7] * q * g1.w}; }
}
__device__ __forceinline__ void rms_rows2_f32_inplace(float* x0, float* x1, const float* gain, int lane) {
    f32x4* xr0 = (f32x4*)x0 + lane; f32x4* xr1 = (f32x4*)x1 + lane; const f32x4* gr = (const f32x4*)gain + lane;
    f32x4 v[4], w[4]; float s = 0.f, t = 0.f;
#pragma unroll
    for (int j = 0; j < 4; ++j) { v[j] = xr0[64 * j]; w[j] = xr1[64 * j]; }
#pragma unroll
    for (int j = 0; j < 4; ++j) { s += (v[j].x * v[j].x + v[j].y * v[j].y) + (v[j].z * v[j].z + v[j].w * v[j].w); t += (w[j].x * w[j].x + w[j].y * w[j].y) + (w[j].z * w[j].z + w[j].w * w[j].w); }
#pragma unroll
    for (int o = 1; o < 64; o <<= 1) { s += __shfl_xor(s, o); t += __shfl_xor(t, o); }
    const float r = rsqrtf(s * (1.f / D) + EPS), q = rsqrtf(t * (1.f / D) + EPS);
#pragma unroll
    for (int j = 0; j < 4; ++j) { const f32x4 gg = gr[64 * j]; xr0[64 * j] = v[j] * r * gg; xr1[64 * j] = w[j] * q * gg; }
}

typedef short v4i16_t __attribute__((ext_vector_type(4)));
template <int KS>
__device__ __forceinline__ void seqmix_load_w(bf16x8 (&w)[KS], const bf16_t* Wrow  ) {
#pragma unroll
    for (int ks = 0; ks < KS; ++ks) {
        const u32x2 w0 = *(const u32x2*)(Wrow + 32 * ks), w1 = *(const u32x2*)(Wrow + 32 * ks + 16);
        const u32x4 wv = (u32x4){w0.x, w0.y, w1.x, w1.y};
        w[ks] = __builtin_bit_cast(bf16x8, wv);
    }
}
template <int NCT>
__device__ __forceinline__ void seqmix_load_dstep(bf16x8 (&d)[NCT], const LAS bf16_t* rb  , int RS) {
#pragma unroll
    for (int i = 0; i < NCT; ++i) {
        const v4i16_t d0 = __builtin_amdgcn_ds_read_tr16_b64_v4i16((LAS v4i16_t*)(rb + 16 * i));
        const v4i16_t d1 = __builtin_amdgcn_ds_read_tr16_b64_v4i16((LAS v4i16_t*)(rb + 16 * RS + 16 * i));
        d[i] = (bf16x8){d0[0], d0[1], d0[2], d0[3], d1[0], d1[1], d1[2], d1[3]};
    }
}
template <int KS, int NCT>
__device__ __forceinline__ void seqmix_mma_tr(f32x4 (&acc)[NCT], const LAS bf16_t* R, int RS, int ct0, const bf16x8 (&w)[KS], int lane) {
    const int g = lane >> 4, li = lane & 15;
    const LAS bf16_t* rbase = R + (4 * g + (li >> 2)) * RS + 16 * ct0 + 4 * (li & 3);
    bf16x8 d[2][NCT];
    seqmix_load_dstep<NCT>(d[0], rbase, RS);
#pragma unroll
    for (int ks = 0; ks < KS; ++ks) {
        if (ks + 1 < KS) seqmix_load_dstep<NCT>(d[(ks + 1) & 1], rbase + 32 * (ks + 1) * RS, RS);
        __builtin_amdgcn_sched_barrier(0);
#pragma unroll
        for (int i = 0; i < NCT; ++i) acc[i] = __builtin_amdgcn_mfma_f32_16x16x32_bf16(d[ks & 1][i], w[ks], acc[i], 0, 0, 0);
        __builtin_amdgcn_sched_barrier(0);
    }
}
template <int KS, int NCT>
__device__ __forceinline__ void seqmix_load_d(bf16x8 (&d)[KS][NCT], const LAS bf16_t* R, int RS, int ct0, int lane) {
    const int g = lane >> 4, li = lane & 15;
    const LAS bf16_t* rbase = R + (4 * g + (li >> 2)) * RS + 16 * ct0 + 4 * (li & 3);
#pragma unroll
    for (int ks = 0; ks < KS; ++ks) seqmix_load_dstep<NCT>(d[ks], rbase + 32 * ks * RS, RS);
}
template <int KS, int NCT>
__device__ __forceinline__ void seqmix_mma_reg(f32x4 (&acc)[NCT], const bf16x8 (&d)[KS][NCT], const bf16x8 (&w)[KS]) {
#pragma unroll
    for (int ks = 0; ks < KS; ++ks)
#pragma unroll
        for (int i = 0; i < NCT; ++i) acc[i] = __builtin_amdgcn_mfma_f32_16x16x32_bf16(d[ks][i], w[ks], acc[i], 0, 0, 0);
}

__global__ void __launch_bounds__(NTHREADS, 2) mega_fwd(Args args) {
    extern __shared__ __attribute__((aligned(16))) unsigned char lds_raw[];
    LAS unsigned char* lds = (LAS unsigned char*)lds_raw;
    cg::grid_group grid = cg::this_grid();
    const int G = gridDim.x, bx = blockIdx.x;
    const int NGW = G * 8, NGT = G * NTHREADS;
    if (threadIdx.x < 4) ((LAS unsigned*)(lds + LDS_MISC))[threadIdx.x] = 0u;
    __syncthreads();
    XcdBarrier xbar; xbar.bar = (unsigned*)(gptr(args.ws) + OFF_BAR); xbar.x = xb_xcc_id(); xbar.st = (volatile LAS unsigned*)(lds + LDS_MISC);
    if (bx == 0) for (int i = threadIdx.x; i < XCD_BAR_WORDS; i += NTHREADS) xbar.bar[i] = 0u;

    if (args.ph_lo == 0) {
        int tid = threadIdx.x; asm volatile("" : "+v"(tid));
        const int lane = tid & 63, wave = __builtin_amdgcn_readfirstlane(tid >> 6);
        const int gw = bx * 8 + wave, gtid = bx * NTHREADS + tid;
        unsigned char* ws = gptr(args.ws);
        bf16_t* W1t = (bf16_t*)(ws + OFF_W1T); bf16_t* W3t = (bf16_t*)(ws + OFF_W3T); bf16_t* W2t = (bf16_t*)(ws + OFF_W2T); bf16_t* W4t = (bf16_t*)(ws + OFF_W4T);
        bf16_t* Wbv = (bf16_t*)(ws + OFF_WBV); bf16_t* Wf = (bf16_t*)(ws + OFF_WF); bf16_t* PwT = (bf16_t*)(ws + OFF_PWT); bf16_t* FwT = (bf16_t*)(ws + OFF_FWT);
        bf16_t* CS = (bf16_t*)(ws + OFF_CS); bf16_t* Wsb = (bf16_t*)(ws + OFF_WSB);
        bf16_t* T1s = (bf16_t*)(ws + OFF_T1S); bf16_t* T1p = (bf16_t*)(ws + OFF_T1P); bf16_t* T2 = (bf16_t*)(ws + OFF_T2);
            {
                LAS float* scr = (LAS float*)(lds + wave * 16384);
                const float* ewin = gptr(args.in[I_EWIN]); const float* owin = gptr(args.in[I_OWIN]);
                const float* g1v = gptr(args.in[I_NORMG]) + D;
                constexpr int NIT = 2048 + 512 + 1024 + 1536 + 512 + 1024 + 128 + 128;
                for (int it = gw; it < NIT; it += NGW) {
                    int r = it;
#define TJ(Wp, ldw_, ncols_, K_, WTp, ldt_, csp, pm_, ksp) { const int n_ = ((K_) / 64) * ((ncols_) / 32); if (r < n_) { transpose_item(Wp, ldw_, ncols_, WTp, ldt_, csp, scr, r, lane, pm_, ksp); continue; } r -= n_; }
                    TJ(ewin, 6144, 4096, 1024, W1t, 1024, nullptr, 1, nullptr)
                    TJ(ewin + 5120, 6144, 1024, 1024, W1t + (size_t)5120 * 1024, 1024, nullptr, 0, nullptr)
                    TJ(gptr(args.in[I_EWOUT]), 1024, 1024, 2048, W2t, 2048, nullptr, 0, nullptr)
                    TJ(owin, 5120, 3072, 1024, W3t, 1024, nullptr, 2, g1v)
                    TJ(owin + 4096, 5120, 1024, 1024, W3t + (size_t)5120 * 1024, 1024, nullptr, 0, g1v)
                    TJ(gptr(args.in[I_OWOUT]), 1024, 1024, 2048, W4t, 2048, nullptr, 0, nullptr)
                    { const int gq = r / 32; if (gq < 4) { transpose_item(gptr(args.in[I_EPOOLW]) + gq * 65536, 256, 256, PwT + gq * 65536, 256, gptr(args.in[I_EPOOLS]) + gq * 256, scr, r % 32, lane); continue; } r -= 128; }
                    { const int gq = r / 32; transpose_item(gptr(args.in[I_OFNET]) + gq * 65536, 256, 256, FwT + gq * 65536, 256, nullptr, scr, r % 32, lane); }
#undef TJ
                }
                constexpr int N_WBV = 131072, N_WF = 131072, N_WSB = 8192, N_CS = 16384, N_T1S = 262144, N_T1P = 16384, N_T2 = 4096;
                constexpr int NEL = N_WBV + N_WF + N_WSB + N_CS + N_T1S + N_T1P + N_T2;
                for (int it = gtid; it < NEL; it += NGT) {
                    int r = it;
                    if (r < N_WBV) { const int d = r >> 7, i8 = r & 127; cvt8(ewin + (size_t)d * 6144 + 4096 + i8 * 8, Wbv + (size_t)d * 1024 + i8 * 8); continue; } r -= N_WBV;
                    if (r < N_WF) { const int d = r >> 7, i8 = r & 127; const float gd = g1v[d]; const float* sp = owin + (size_t)d * 5120 + 3072 + i8 * 8; const f32x4 a = *(const f32x4*)sp * gd, b = *(const f32x4*)(sp + 4) * gd;
                        u32x4 o; o.x = pk2(a.x, a.y); o.y = pk2(a.z, a.w); o.z = pk2(b.x, b.y); o.w = pk2(b.z, b.w); *(u32x4*)(Wf + (size_t)d * 1024 + i8 * 8) = o; continue; } r -= N_WF;
                    if (r < N_WSB) { cvt8(gptr(args.in[I_OSGUW]) + (size_t)r * 8, Wsb + (size_t)r * 8); continue; } r -= N_WSB;
                    float o[8]; bf16_t* dst;
                    if (r < N_CS) { const int n = r >> 5, l0 = (r & 31) * 8;
#pragma unroll
                        for (int e = 0; e < 8; ++e) { const int idx = ((n & 255) * (l0 + e)) & 255; float sn, cs; sincospif((float)idx * (1.f / 128.f), &sn, &cs); o[e] = (n < 256) ? cs : sn; }
                        dst = CS + (size_t)r * 8;
                    } else if ((r -= N_CS) < N_T1S) { const int s2 = r >> 11, q = (r >> 4) & 127, p0 = (r & 15) * 8; const int k1 = q >> 1, ri = q & 1;
#pragma unroll
                        for (int e = 0; e < 8; ++e) { const int p = p0 + e, part = p >> 6, s1 = p & 63; const int idx = (k1 * (s1 * 128 + s2)) & 8191; float sn, cs; sincospif((float)idx * (1.f / 4096.f), &sn, &cs);
                            o[e] = (ri == 0) ? (part == 0 ? cs : -sn) : (part == 0 ? -sn : -cs); }
                        dst = T1s + (size_t)r * 8;
                    } else if ((r -= N_T1S) < N_T1P) { const int s2 = r >> 7, q = (r >> 2) & 31, p0 = (r & 3) * 8; const int k1 = q >> 1, ri = q & 1;
#pragma unroll
                        for (int e = 0; e < 8; ++e) { const int p = p0 + e, part = p >> 4, s1 = p & 15; const int idx = (k1 * (s1 * 128 + s2)) & 2047; float sn, cs; sincospif((float)idx * (1.f / 1024.f), &sn, &cs);
                            o[e] = (ri == 0) ? (part == 0 ? cs : -sn) : (part == 0 ? -sn : -cs); }
                        dst = T1p + (size_t)r * 8;
                    } else { r -= N_T1P; const int k2 = r >> 5, p0 = (r & 31) * 8;
#pragma unroll
                        for (int e = 0; e < 8; ++e) { const int p = p0 + e, s2 = p >> 1, ri = p & 1; const int idx = (s2 * k2) & 127; float sn, cs; sincospif((float)idx * (1.f / 64.f), &sn, &cs); o[e] = ri ? sn : cs; }
                        dst = T2 + (size_t)r * 8;
                    }
                    st8(dst, o);
                }
            }
    }
#ifndef PROBE_K
#define PROBE_K (-1)
#endif
    for (int ph = args.ph_lo; ph < args.ph_hi; ++ph)
    for (int rep = 0; rep < ((PROBE_K >= 0 && ph == PROBE_K) ? 2 : 1); ++rep) {
        int tid = threadIdx.x; asm volatile("" : "+v"(tid));
        const int lane = tid & 63, wave = __builtin_amdgcn_readfirstlane(tid >> 6);
        const int gw = bx * 8 + wave, gtid = bx * NTHREADS + tid;
        __attribute__((address_space(1))) unsigned char* wsg = (__attribute__((address_space(1))) unsigned char*)args.ws; asm volatile("" : "+s"(wsg)); unsigned char* ws = (unsigned char*)wsg;
        bf16_t* W1t = (bf16_t*)(ws + OFF_W1T); bf16_t* W3t = (bf16_t*)(ws + OFF_W3T); bf16_t* W2t = (bf16_t*)(ws + OFF_W2T); bf16_t* W4t = (bf16_t*)(ws + OFF_W4T);
        bf16_t* Wbv = (bf16_t*)(ws + OFF_WBV); bf16_t* Wf = (bf16_t*)(ws + OFF_WF); bf16_t* PwT = (bf16_t*)(ws + OFF_PWT); bf16_t* FwT = (bf16_t*)(ws + OFF_FWT);
        bf16_t* CS = (bf16_t*)(ws + OFF_CS); bf16_t* MT = (bf16_t*)(ws + OFF_MT); bf16_t* Wsb = (bf16_t*)(ws + OFF_WSB);
        bf16_t* T1s = (bf16_t*)(ws + OFF_T1S); bf16_t* T1p = (bf16_t*)(ws + OFF_T1P); bf16_t* T2 = (bf16_t*)(ws + OFF_T2);
        bf16_t* H = (bf16_t*)(ws + OFF_H); bf16_t* P = (bf16_t*)(ws + OFF_P); bf16_t* Y = (bf16_t*)(ws + OFF_Y); bf16_t* V = (bf16_t*)(ws + OFF_V);
        const float* norm_g = gptr(args.in[I_NORMG]);
        int njobs = 0; int jobk[3] = {0, 0, 0};
        int grp = 0;
        int norm0_grp = -1;
        if (ph == 0) {
            norm0_grp = 0;
        } else if (ph == 1) {
            njobs = 2; jobk[0] = 10; jobk[1] = 11;
        } else {
            int k;
            if (ph < 8) { grp = (ph - 2) >> 1; k = (ph - 2) & 1; }
            else if (ph == 8) { k = 2; }
            else if (ph < 18) { grp = (ph - 9) / 3; k = 4 + (ph - 9) % 3; }
            else { k = ph - 11; }
            bf16_t* Yg = Y + (size_t)grp * GT * YP;
            int norm1_grp = -1;
            const int S = grp == 0 ? 2048 : 8192;
            if (k == 0) { njobs = 1; jobk[0] = 1; if (grp == 0) { njobs = 3; jobk[1] = 12; jobk[2] = 13; } }
            else if (k == 1) {
                const float* convw = gptr(args.in[I_ECONV]);
                for (int wt = gw; wt < (GT / 16) * 8; wt += NGW) {
                    const int seg = ((wt & 7) + 2 * (wt / NGW)) & 7, tb = (wt >> 3) * 2 + (lane >> 5);
                    const int r0 = tb * 8, c = (seg & 3) * 256 + (lane & 31) * 8;
                    if (seg < 4) conv_item(P, Yg, convw, r0, c, S);
                    else if (seg == 4) pool_item<1>(P, Yg, r0, c, S);
                    else if (seg == 5) pool_item<2>(P, Yg, r0, c, S);
                    else if (seg == 6) pool_item<4>(P, Yg, r0, c, S);
                    else pool_item<8>(P, Yg, r0, c, S);
                }
                if (grp + 1 < NGRP) norm0_grp = grp + 1;
            }
            else if (k == 2) { njobs = 1; jobk[0] = 2; }
            else if (k == 3) { norm1_grp = 0; }
            else if (k == 4) { njobs = 1; jobk[0] = 3; }
            else if (k == 5) {
#ifndef PROBE_SUB
#define PROBE_SUB (-1)
#endif
                if (!(rep == 1 && PROBE_SUB == 1)) {
                    LAS bf16_t* R = (LAS bf16_t*)lds; constexpr int RS = 272; constexpr int NT = (GT / 128) * 4;
                    const float* gn = gptr(args.in[I_OSGUG]); const float* bs = gptr(args.in[I_OSGUB]);
                    for (int tile = bx; tile < NT; tile += G) {
                        const int chunk = tile >> 2, hd = tile & 3;
                        const int hrow = lane >> 5, l32 = lane & 31;
                        const bf16_t* src = P + (size_t)(chunk * 128 + wave * 16 + hrow) * NP1 + hd * 256 + 8 * l32;
                        u32x4 raw[8], ru[8];
#pragma unroll
                        for (int j = 0; j < 8; ++j) { raw[j] = *(const u32x4*)(src + (size_t)(2 * j) * NP1 + 1024); ru[j] = *(const u32x4*)(src + (size_t)(2 * j) * NP1); }
                        bf16x8 wfr[4];
                        seqmix_load_w<4>(wfr, Wsb + (size_t)hd * 16384 + (size_t)(16 * wave + (lane & 15)) * 128 + 4 * (lane >> 4));
                        const f32x4 g0 = *(const f32x4*)(gn + hd * 256 + 8 * l32), g1 = *(const f32x4*)(gn + hd * 256 + 8 * l32 + 4);
                        float s1[8], s2[8];
#pragma unroll
                        for (int j = 0; j < 8; ++j) { float v[8]; cvt8u(raw[j], v); s1[j] = 0.f; s2[j] = 0.f;
#pragma unroll
                            for (int e = 0; e < 8; ++e) { s1[j] += v[e]; s2[j] += v[e] * v[e]; } }
#pragma unroll
                        for (int o = 1; o < 32; o <<= 1) {
#pragma unroll
                            for (int j = 0; j < 8; ++j) { s1[j] += __shfl_xor(s1[j], o); s2[j] += __shfl_xor(s2[j], o); } }
                        LAS bf16_t* UZ = (LAS bf16_t*)(lds + 69632);
#pragma unroll
                        for (int j = 0; j < 8; ++j) {
                            const int prow_ln = wave * 16 + 2 * j + hrow;
                            const float mu = s1[j] * (1.f / 256.f), var = fmaxf(s2[j] * (1.f / 256.f) - mu * mu, 0.f);
                            const float rs = rsqrtf(var + EPS);
                            float v[8]; cvt8u(raw[j], v);
                            u32x4 o4;
                            o4.x = pk2((v[0] - mu) * rs * g0.x, (v[1] - mu) * rs * g0.y); o4.y = pk2((v[2] - mu) * rs * g0.z, (v[3] - mu) * rs * g0.w);
                            o4.z = pk2((v[4] - mu) * rs * g1.x, (v[5] - mu) * rs * g1.y); o4.w = pk2((v[6] - mu) * rs * g1.z, (v[7] - mu) * rs * g1.w);
                            *(LAS u32x4*)(R + prow_ln * RS + 8 * l32) = o4;
                            *(LAS u32x4*)(UZ + prow_ln * RS + 8 * l32) = ru[j];
                        }
                        __syncthreads();
                        const int q = 16 * wave + (lane & 15);
                        const LAS bf16_t* uzrow = UZ + q * RS + 4 * (lane >> 4);
                        const float bias = bs[hd * 128 + q];
                        f32x4 acc[16];
#pragma unroll
                        for (int i = 0; i < 16; ++i) acc[i] = (f32x4){0.f, 0.f, 0.f, 0.f};
                        seqmix_mma_tr<4, 16>(acc, R, RS, 0, wfr, lane);
                        bf16_t* yrow = Yg + (size_t)(chunk * 128 + q) * YP + hd * 256 + 4 * (lane >> 4);
#pragma unroll
                        for (int i = 0; i < 16; ++i) {
                            const u32x2 uz = *(const LAS u32x2*)(uzrow + 16 * i);
                            u32x2 o;
                            o.x = pk2(bflo(uz.x) * (acc[i][0] + bias), bfhi(uz.x) * (acc[i][1] + bias));
                            o.y = pk2(bflo(uz.y) * (acc[i][2] + bias), bfhi(uz.y) * (acc[i][3] + bias));
                            *(u32x2*)(yrow + 16 * i) = o;
                        }
                        __syncthreads();
                    }
                }
                if (!(rep == 1 && PROBE_SUB == 0)) {
                    constexpr int RSW = 72;
                    LAS bf16_t* R = (LAS bf16_t*)(lds + wave * 18432);
                    const int g4 = lane >> 4, li = lane & 15;
                    if (grp != 0) {
#define DFT1S_LOAD(W_) do { const int cs_ = (W_) & 15, s2_ = ((W_) >> 4) & 127, bl_ = (W_) >> 11; \
    _Pragma("unroll") for (int i = 0; i < 32; ++i) { const int row = 4 * i + g4, part = row >> 6, s1 = row & 63; \
        raw[i] = *(const u32x2*)(P + (size_t)(bl_ * 8192 + s1 * 128 + s2_) * NP1 + 2048 + part * 1024 + cs_ * 64 + 4 * li); } } while (0)
                        constexpr int NWT = 2 * 128 * 16;
                        u32x2 raw[32];
                        { const int w0 = gw < NWT ? gw : 0; DFT1S_LOAD(w0); }
                        for (int wt = gw; wt < NWT; wt += NGW) {
                            const int cs = wt & 15, s2 = (wt >> 4) & 127, bl = wt >> 11;
#pragma unroll
                            for (int i = 0; i < 32; ++i) *(LAS u32x2*)(R + (4 * i + g4) * RSW + 4 * li) = raw[i];
                            asm volatile("" ::: "memory");
                            { const int wn_ = wt + NGW < NWT ? wt + NGW : wt; DFT1S_LOAD(wn_); }
                            bf16x8 wc[4], wn[4];
                            const bf16_t* wbase = T1s + (size_t)s2 * 16384 + (size_t)li * 128 + 4 * g4;
                            seqmix_load_w<4>(wc, wbase);
                            bf16x8 dfr[4][4];
                            seqmix_load_d<4, 4>(dfr, R, RSW, 0, lane);
#pragma unroll
                            for (int qt = 0; qt < 8; ++qt) {
                                if (qt < 7) seqmix_load_w<4>(wn, wbase + (size_t)(16 * (qt + 1)) * 128);
                                f32x4 acc[4];
#pragma unroll
                                for (int i = 0; i < 4; ++i) acc[i] = (f32x4){0.f, 0.f, 0.f, 0.f};
                                const int q = 16 * qt + li, k1 = q >> 1, ri = q & 1;
                                seqmix_mma_reg<4, 4>(acc, dfr, wc);
                                bf16_t* vrow = V + ((size_t)((bl * 64 + k1) * VBLK + s2 * 2 + ri)) * 1024 + cs * 64 + 4 * g4;
#pragma unroll
                                for (int i = 0; i < 4; ++i) { u32x2 o; o.x = pk2(acc[i][0], acc[i][1]); o.y = pk2(acc[i][2], acc[i][3]); *(u32x2*)(vrow + 16 * i) = o; }
#pragma unroll
                                for (int ks = 0; ks < 4; ++ks) wc[ks] = wn[ks];
                            }
                            asm volatile("" ::: "memory");
                        }
#undef DFT1S_LOAD
                    } else {
                        for (int wt = gw; wt < 8 * 32 * 16; wt += NGW) {
                            const int cs = wt & 15, sq = (wt >> 4) & 31, bl = wt >> 9;
                            u32x2 raw[32];
#pragma unroll
                            for (int i = 0; i < 32; ++i) { const int row = 4 * i + g4, j = row >> 5, part = (row >> 4) & 1, s1 = row & 15;
                                raw[i] = *(const u32x2*)(P + (size_t)(bl * 2048 + s1 * 128 + 4 * sq + j) * NP1 + 2048 + part * 1024 + cs * 64 + 4 * li); }
#pragma unroll
                            for (int i = 0; i < 32; ++i) *(LAS u32x2*)(R + (4 * i + g4) * RSW + 4 * li) = raw[i];
                            asm volatile("" ::: "memory");
                            bf16x8 dfp[4][1][4];
#pragma unroll
                            for (int j = 0; j < 4; ++j) seqmix_load_d<1, 4>(dfp[j], R + 32 * j * RSW, RSW, 0, lane);
                            bf16x8 wp[8][1];
#pragma unroll
                            for (int jq = 0; jq < 8; ++jq) seqmix_load_w<1>(wp[jq], T1p + (size_t)(4 * sq + (jq >> 1)) * 1024 + (size_t)(16 * (jq & 1) + li) * 32 + 4 * g4);
#pragma unroll
                            for (int jq = 0; jq < 8; ++jq) {
                                const int j = jq >> 1, qt = jq & 1, s2 = 4 * sq + j;
                                f32x4 acc[4];
#pragma unroll
                                for (int i = 0; i < 4; ++i) acc[i] = (f32x4){0.f, 0.f, 0.f, 0.f};
                                const int q = 16 * qt + li, k1 = q >> 1, ri = q & 1;
                                seqmix_mma_reg<1, 4>(acc, dfp[j], wp[jq]);
                                bf16_t* vrow = V + ((size_t)((bl * 16 + k1) * VBLK + s2 * 2 + ri)) * 1024 + cs * 64 + 4 * g4;
#pragma unroll
                                for (int i = 0; i < 4; ++i) { u32x2 o; o.x = pk2(acc[i][0], acc[i][1]); o.y = pk2(acc[i][2], acc[i][3]); *(u32x2*)(vrow + 16 * i) = o; }
                            }
                            asm volatile("" ::: "memory");
                        }
                    }
                    __syncthreads();
                }
            }
            else if (k == 6) {
                LAS bf16_t* R = (LAS bf16_t*)lds; constexpr int RS = 144;
                const int N1 = grp == 0 ? 16 : 64, nseq = grp == 0 ? 8 : 2;
                const int NT = nseq * N1 * 8;
                const float scale = grp == 0 ? 0.001381067932f : 0.0006905339660f;
#define DFT2_LOAD(T_) do { const bf16_t* vb_ = V + (size_t)(((T_) >> 3) * VBLK) * 1024 + ((T_) & 7) * 128 + 4 * (lane & 31); \
    _Pragma("unroll") for (int i = 0; i < 16; ++i) raw[i] = *(const u32x2*)(vb_ + (size_t)(2 * (wave + 8 * i) + (lane >> 5)) * 1024); } while (0)
                for (int tile = bx; tile < NT; tile += G) {
                    const int cs = tile & 7, k1 = (tile >> 3) % N1, bl = (tile >> 3) / N1;
                    u32x2 raw[16];
                    DFT2_LOAD(tile);
                    bf16x8 wfr[8];
                    seqmix_load_w<8>(wfr, T2 + (size_t)(16 * wave + (lane & 15)) * 256 + 4 * (lane >> 4));
#pragma unroll
                    for (int i = 0; i < 16; ++i) *(LAS u32x2*)(R + (2 * (wave + 8 * i) + (lane >> 5)) * RS + 4 * (lane & 31)) = raw[i];
                    __syncthreads();
                    const int k2 = 16 * wave + (lane & 15);
                    const size_t tok = (size_t)bl * S + k1 + (size_t)N1 * k2;
                    const bf16_t* zrow = P + tok * NP1 + 4096 + cs * 128 + 4 * (lane >> 4);
                    u32x2 zr[8];
#pragma unroll
                    for (int i = 0; i < 8; ++i) zr[i] = *(const u32x2*)(zrow + 16 * i);
                    f32x4 acc[8];
#pragma unroll
                    for (int i = 0; i < 8; ++i) acc[i] = (f32x4){0.f, 0.f, 0.f, 0.f};
                    seqmix_mma_tr<8, 8>(acc, R, RS, 0, wfr, lane);
                    bf16_t* yrow = Yg + tok * YP + 1024 + cs * 128 + 4 * (lane >> 4);
#pragma unroll
                    for (int i = 0; i < 8; ++i) {
                        u32x2 o;
                        o.x = pk2(acc[i][0] * scale * bflo(zr[i].x), acc[i][1] * scale * bfhi(zr[i].x));
                        o.y = pk2(acc[i][2] * scale * bflo(zr[i].y), acc[i][3] * scale * bfhi(zr[i].y));
                        *(u32x2*)(yrow + 16 * i) = o;
                    }
                    __syncthreads();
                }
#undef DFT2_LOAD
            }
            else if (k == 7) { njobs = 1; jobk[0] = 4; }
            else {
                float* xo = gptr(args.out); const bf16_t* x2 = P;
                for (int m = 4 * gw; m < NTOK; m += 4 * NGW) rms_rowsN_bf16_to_f32<4>(x2 + (size_t)m * D, gptr(args.in[I_FINALG]), xo + (size_t)m * D, lane);
            }
            if (norm1_grp >= 0) {
                const bf16_t* x1 = (const bf16_t*)gptr(args.out) + (size_t)norm1_grp * GT * D;
                for (int m = 2 * gw; m < GT; m += 2 * NGW) rms_rows2_bf16_in(x1 + (size_t)m * D, x1 + (size_t)(m + 1) * D, norm_g + D, H + (size_t)m * D, H + (size_t)(m + 1) * D, lane);
            }
        }
        if (norm0_grp >= 0) {
            const float* xg = norm0_grp == 0 ? gptr(args.in[I_XP]) : gptr(args.in[I_XS]) + (size_t)(norm0_grp - 1) * GT * D;
            for (int m = 4 * gw; m < GT; m += 4 * NGW) rms_rowsN_bf16<4>(xg + (size_t)m * D, norm_g, H + (size_t)m * D, lane);
        }
        for (int j = 0; j < njobs; ++j) {
            const int kind = jobk[j];
            pg8::Gemm g; g.res = nullptr; g.res2 = nullptr; g.split_pm = 0; g.out = nullptr; g.resb = nullptr; g.outb = nullptr; g.stats_w = nullptr; g.stats_r = nullptr; g.O = nullptr; g.sA = 0; g.sB = 0; g.sO = 0; g.nB = 1; g.emode = 0;
            bool resmode = false;
            if (kind == 1) { g.A = H; g.Bt = W1t; g.lda = 1024; g.ldb = 1024; g.K = 1024; g.nM = GT / 256; g.nN = NP / 256; g.O = P; g.ldc = NP0; g.emode = 1; }
            else if (kind == 3) { g.A = (const bf16_t*)gptr(args.out) + (size_t)grp * GT * D; g.Bt = W3t; g.lda = 1024; g.ldb = 1024; g.K = 1024; g.nM = GT / 256; g.nN = NP / 256; g.O = P; g.ldc = NP1; g.emode = 2;
                g.stats_r = (const float*)(ws + OFF_STAT) + (size_t)grp * GT * 16; }
            else if (kind == 2) { g.A = Y; g.Bt = W2t; g.lda = YP; g.ldb = 2048; g.K = 2048; g.nM = NTOK / 256; g.nN = 4; g.ldc = 1024; resmode = true;
                g.res = gptr(args.in[I_XP]); g.res2 = gptr(args.in[I_XS]) - (size_t)GT * D; g.split_pm = GT / 256; g.outb = (bf16_t*)gptr(args.out); g.stats_w = (float*)(ws + OFF_STAT); }
            else if (kind == 4) { g.A = Y; g.Bt = W4t; g.lda = YP; g.ldb = 2048; g.K = 2048; g.nM = NTOK / 256; g.nN = 4; g.ldc = 1024; resmode = true;
                g.resb = (const bf16_t*)gptr(args.out); g.outb = P; }
            else if (kind == 10) { g.A = FwT; g.Bt = CS; g.lda = 256; g.ldb = 256; g.K = 256; g.sA = 65536; g.sB = 0; g.nM = 1; g.nN = 2; g.nB = 4; g.O = MT; g.ldc = 512; g.sO = 131072; }
            else if (kind == 11) { g.A = PwT; g.Bt = Wbv; g.lda = 256; g.ldb = 1024; g.K = 256; g.sA = 65536; g.sB = 256; g.nM = 1; g.nN = 4; g.nB = 4; g.O = W1t + (size_t)4096 * 1024; g.ldc = 1024; g.sO = 262144; }
            else { const int part = kind - 12; g.A = MT + part * 256; g.Bt = Wf; g.lda = 512; g.ldb = 1024; g.K = 256; g.sA = 131072; g.sB = 256; g.nM = 1; g.nN = 4; g.nB = 4;
                g.O = W3t + (size_t)(3072 + part * 1024) * 1024; g.ldc = 1024; g.sO = 262144; }
            pg8::Sched S; S.nM = g.nM; S.nN = g.nN; S.nwg = g.nM * g.nN; S.nB = g.nB; S.G = G; S.c = bx;
            if (kind == 11 || kind == 13) S.c = (bx + G - 16) % G;
            if (resmode) pg8::gemm_phase<pg8::EpiRes>(lds, g, S, pg8::EpiRes{}, tid);
            else pg8::gemm_phase<pg8::EpiBf16>(lds, g, S, pg8::EpiBf16{}, tid);
            __syncthreads();
        }
        if (ph + 1 < args.ph_hi || (PROBE_K >= 0 && rep == 0 && ph == PROBE_K)) {
            if (ph == 0) { grid.sync();
                if (threadIdx.x == 0) (void)xb_add(&xbar.bar[XB_XCNT(xbar.x)], 1u); }
            else xcd_barrier(xbar); }
    }
#ifdef PROBE_SYNCS
    for (int i = 0; i < PROBE_SYNCS; ++i) grid.sync();
#endif
}

extern "C" void kernel_launch(void* const* d_in, const int* in_sizes, int n_in, void* d_out, int out_size, void* d_ws, size_t ws_size, hipStream_t stream) {
    static int grid = 0;
    if (grid == 0) {
        int dev = 0, cus = 0, per_cu = 0;
        if (hipGetDevice(&dev) != hipSuccess || hipDeviceGetAttribute(&cus, hipDeviceAttributeMultiprocessorCount, dev) != hipSuccess) { fprintf(stderr, "kernel_launch: device query failed\n"); grid = -1; return; }
        if (hipFuncSetAttribute((const void*)mega_fwd, hipFuncAttributeMaxDynamicSharedMemorySize, LDS_BYTES) != hipSuccess) { fprintf(stderr, "kernel_launch: hipFuncSetAttribute failed\n"); grid = -1; return; }
        if (hipOccupancyMaxActiveBlocksPerMultiprocessor(&per_cu, (const void*)mega_fwd, NTHREADS, LDS_BYTES) != hipSuccess || per_cu < 1) { fprintf(stderr, "kernel_launch: occupancy query failed (%d)\n", per_cu); grid = -1; return; }
        if (per_cu > 1) per_cu = 1;
        grid = cus * per_cu;
        if (ws_size < OFF_V + (size_t)128 * VBLK * 2048) { fprintf(stderr, "kernel_launch: workspace too small (%zu)\n", ws_size); grid = -1; return; }
    }
    if (grid < 0) return;
    Args a{};
    for (int i = 0; i < 15; ++i) a.in[i] = (const float*)d_in[i];
    a.out = (float*)d_out; a.ws = (unsigned char*)d_ws; a.ph_lo = 0; a.ph_hi = NPHASES;
    void* kargs[] = {&a};
    hipError_t e = hipLaunchCooperativeKernel((const void*)mega_fwd, dim3(grid), dim3(NTHREADS), kargs, LDS_BYTES, stream);
    if (e != hipSuccess) fprintf(stderr, "cooperative launch failed: %s (grid %d)\n", hipGetErrorString(e), grid);
}
```
